# Optimizing an MI355X kernel written in HIP

```python
import math
import jax, jax.numpy as jnp
from jax import lax
import numpy as np

D_MODEL = 1024
BATCH = 16
SEQ = 2048
DEPTH = 2
DEC_BATCH = 1
DEC_SEQ = 16384
PAST_LEN = 128

W_POOL = D_MODEL
W_SSM = D_MODEL
W_MIX = W_POOL + W_SSM
POOL_WINDOWS = (2, 4, 8, 16)
N_POOL_GROUPS = len(POOL_WINDOWS)
POOL_GROUP = W_POOL // N_POOL_GROUPS
SSM_H = 16
SSM_G = W_SSM // SSM_H
SSM_P = 64
N_DIR = 2
IN_COLS = 2 * W_POOL + 2 * W_SSM
EPS = 1e-6
STEP_MIN = 1e-3
STEP_MAX = 1e-1

kernel_name = 'hybrid_pool_s5_bidir_encoder'


def rmsnorm(x, g):
    xf = x.astype(jnp.float32)
    inv = lax.rsqrt(jnp.mean(xf * xf, axis=-1, keepdims=True) + EPS)
    return (xf * inv * g.astype(jnp.float32)).astype(x.dtype)


def pool_branch(u, pool_w, pool_scale):
    bsz, L, _ = u.shape
    uf = u.astype(jnp.float32)
    cs = jnp.concatenate([jnp.zeros((bsz, 1, W_POOL), jnp.float32), jnp.cumsum(uf, axis=1)], axis=1)
    pos = jnp.arange(L)
    outs = []
    for g, win in enumerate(POOL_WINDOWS):
        lo = jnp.clip(pos - win // 2, 0, L)
        hi = jnp.clip(pos + win // 2, 0, L)
        sl = slice(g * POOL_GROUP, (g + 1) * POOL_GROUP)
        csg = cs[:, :, sl]
        win_sum = jnp.take(csg, hi, axis=1) - jnp.take(csg, lo, axis=1)
        cnt = (hi - lo).astype(jnp.float32)[None, :, None]
        outs.append(win_sum / cnt - uf[:, :, sl])
    pooled = jnp.stack(outs, axis=2).astype(pool_w.dtype)
    mixed = jnp.einsum('blgc,gcd->blgd', pooled, pool_w).reshape(bsz, L, W_POOL)
    return mixed * pool_scale


def _ssm_combine(left, right):
    a_i, b_i = left
    a_j, b_j = right
    return a_j * a_i, a_j * b_i + b_j


def ssm_branch(u, lam_re, lam_im, log_step, b_re, b_im, c_re, c_im, d_skip, glu_w1, glu_b1, glu_w2, glu_b2):
    bsz, L, _ = u.shape
    f32 = jnp.float32
    uf = u.astype(f32)
    uc = uf.reshape(bsz, L, SSM_G, SSM_H).astype(jnp.complex64)
    y = d_skip.astype(f32) * uf
    for d in range(N_DIR):
        lam = lax.complex(lam_re[d].astype(f32), lam_im[d].astype(f32))
        step = jnp.exp(log_step[d].astype(f32))[:, None]
        lam_bar = jnp.exp(lam * step)
        bmat = lax.complex(b_re[d].astype(f32), b_im[d].astype(f32))
        b_bar = ((lam_bar - 1.0) / lam)[..., None] * bmat
        bu = jnp.einsum('blgh,gph->blgp', uc, b_bar)
        a = jnp.broadcast_to(lam_bar, (L, SSM_G, SSM_P))
        scan_one = lambda bu_seq, a=a, rev=(d == 1): lax.associative_scan(_ssm_combine, (a, bu_seq), reverse=rev, axis=0)[1]
        states = jax.vmap(scan_one)(bu)
        cmat = lax.complex(c_re[d].astype(f32), c_im[d].astype(f32))
        y = y + jnp.real(jnp.einsum('blgp,ghp->blgh', states, cmat)).reshape(bsz, L, W_SSM)
    y = jax.nn.gelu(y).astype(glu_w1.dtype)
    y = (y @ glu_w1 + glu_b1) * jax.nn.sigmoid(y @ glu_w2 + glu_b2)
    return y.astype(u.dtype)


def trunk(x, norm_g, w_in, pool_w, pool_scale, lam_re, lam_im, log_step, b_re, b_im, c_re, c_im, d_skip, glu_w1, glu_b1, glu_w2, glu_b2, w_out, final_g):
    for l in range(DEPTH):
        h = rmsnorm(x, norm_g[l])
        z = h @ w_in[l]
        u_p = z[..., :W_POOL]
        g_p = z[..., W_POOL:2 * W_POOL]
        u_s = z[..., 2 * W_POOL:2 * W_POOL + W_SSM]
        g_s = z[..., 2 * W_POOL + W_SSM:]
        out_p = pool_branch(u_p, pool_w[l], pool_scale[l]) * jax.nn.silu(g_p)
        out_s = ssm_branch(u_s, lam_re[l], lam_im[l], log_step[l], b_re[l], b_im[l], c_re[l], c_im[l], d_skip[l], glu_w1[l], glu_b1[l], glu_w2[l], glu_b2[l]) * jax.nn.silu(g_s)
        merged = jnp.concatenate([out_p, out_s], axis=-1)
        x = x + merged @ w_out[l]
    return rmsnorm(x, final_g)


def setup_inputs(seed: int = 0) -> dict:
    key = jax.random.key(seed)
    ks = jax.random.split(key, 24)
    f32 = jnp.float32
    nrm = lambda k, shape, s: jax.random.normal(k, shape, f32) * s
    n_idx = jnp.arange(SSM_P, dtype=f32)
    return {
        'x_prompt': nrm(ks[0], (BATCH, SEQ, D_MODEL), 1.0),
        'x_sample': nrm(ks[1], (DEC_BATCH, DEC_SEQ, D_MODEL), 1.0),
        'norm_g': 1.0 + nrm(ks[2], (DEPTH, D_MODEL), 0.02),
        'w_in': nrm(ks[3], (DEPTH, D_MODEL, IN_COLS), D_MODEL ** -0.5),
        'pool_w': nrm(ks[4], (DEPTH, N_POOL_GROUPS, POOL_GROUP, POOL_GROUP), POOL_GROUP ** -0.5),
        'pool_scale': 1.0 + nrm(ks[5], (DEPTH, W_POOL), 0.02),
        'lam_re': -0.5 + nrm(ks[6], (DEPTH, N_DIR, SSM_G, SSM_P), 0.01),
        'lam_im': math.pi * n_idx + nrm(ks[7], (DEPTH, N_DIR, SSM_G, SSM_P), 0.01),
        'log_step': jax.random.uniform(ks[8], (DEPTH, N_DIR, SSM_G), f32, math.log(STEP_MIN), math.log(STEP_MAX)),
        'b_re': nrm(ks[9], (DEPTH, N_DIR, SSM_G, SSM_P, SSM_H), (2 * SSM_H) ** -0.5),
        'b_im': nrm(ks[10], (DEPTH, N_DIR, SSM_G, SSM_P, SSM_H), (2 * SSM_H) ** -0.5),
        'c_re': nrm(ks[11], (DEPTH, N_DIR, SSM_G, SSM_H, SSM_P), SSM_P ** -0.5),
        'c_im': nrm(ks[12], (DEPTH, N_DIR, SSM_G, SSM_H, SSM_P), SSM_P ** -0.5),
        'd_skip': nrm(ks[13], (DEPTH, W_SSM), 1.0),
        'glu_w1': nrm(ks[14], (DEPTH, W_SSM, W_SSM), W_SSM ** -0.5),
        'glu_b1': nrm(ks[15], (DEPTH, W_SSM), 0.01),
        'glu_w2': nrm(ks[16], (DEPTH, W_SSM, W_SSM), W_SSM ** -0.5),
        'glu_b2': nrm(ks[17], (DEPTH, W_SSM), 0.01),
        'w_out': nrm(ks[18], (DEPTH, W_MIX, D_MODEL), W_MIX ** -0.5),
        'final_g': 1.0 + nrm(ks[19], (D_MODEL,), 0.02),
    }


def reference(x_prompt, x_sample, norm_g, w_in, pool_w, pool_scale, lam_re, lam_im, log_step, b_re, b_im, c_re, c_im, d_skip, glu_w1, glu_b1, glu_w2, glu_b2, w_out, final_g):
    y_prompt = trunk(x_prompt, norm_g, w_in, pool_w, pool_scale, lam_re, lam_im, log_step, b_re, b_im, c_re, c_im, d_skip, glu_w1, glu_b1, glu_w2, glu_b2, w_out, final_g)
    y_sample = trunk(x_sample, norm_g, w_in, pool_w, pool_scale, lam_re, lam_im, log_step, b_re, b_im, c_re, c_im, d_skip, glu_w1, glu_b1, glu_w2, glu_b2, w_out, final_g)
    return (y_prompt, y_sample)
```

```cpp
#include <hip/hip_runtime.h>
#include <hip/hip_cooperative_groups.h>
#include <cstdio>
#include <cstdint>
namespace cg = cooperative_groups;

#define LAS __attribute__((address_space(3)))
#define GAS __attribute__((address_space(1)))
typedef unsigned short bf16;
typedef short bf16x8 __attribute__((ext_vector_type(8)));
typedef float f32x4 __attribute__((ext_vector_type(4)));
typedef float f32x2 __attribute__((ext_vector_type(2)));
typedef unsigned u32x4 __attribute__((ext_vector_type(4)));
typedef unsigned u32x2 __attribute__((ext_vector_type(2)));

constexpr int T = 49152;
constexpr int TP = 32768;
constexpr int DM = 1024;
constexpr int NCOL = 4096;
constexpr int QC = 32;
constexpr int NCH = T / QC;
constexpr int NG = 64;
constexpr int UXW = 768;
constexpr float EPS = 1e-6f;

constexpr size_t MiB = 1u << 20;
constexpr size_t WS_CTL = 0, CTL_ZERO_BYTES = 1 * MiB;
constexpr size_t WS_SSQ = 256 * 1024;
constexpr size_t WS_BT1 = 4 * MiB;
constexpr size_t WS_BTG = 20 * MiB;
constexpr size_t WS_BTO = 28 * MiB;
constexpr size_t WS_W1OP = 36 * MiB;
constexpr size_t WS_TW = 68 * MiB;
constexpr size_t WS_R1 = 164 * MiB;
constexpr size_t WS_R2 = 260 * MiB;
constexpr size_t WS_UX = 356 * MiB;
constexpr size_t WS_MG = 500 * MiB;
constexpr size_t WS_END = 692 * MiB;
static_assert(WS_SSQ + 3 * (size_t)T * 4 <= CTL_ZERO_BYTES, "ssq inside memset region");
constexpr int CW_BAR = 4096;

constexpr int LDS_BYTES = 147456;
constexpr int MISC_OFF = LDS_BYTES - 64;
constexpr int NWAVES = 8;

#define LDS_WAIT() asm volatile("s_waitcnt lgkmcnt(0)" ::: "memory")
#define VM_WAIT() asm volatile("s_waitcnt vmcnt(0)" ::: "memory")

__device__ __forceinline__ unsigned cvt_pk_bf16(float lo, float hi) { unsigned r; asm volatile("v_cvt_pk_bf16_f32 %0, %1, %2" : "=v"(r) : "v"(lo), "v"(hi)); return r; }
__device__ __forceinline__ float bf_lo(unsigned w) { return __uint_as_float(w << 16); }
__device__ __forceinline__ float bf_hi(unsigned w) { return __uint_as_float(w & 0xffff0000u); }
__device__ __forceinline__ float fast_sigmoid(float x) { return __builtin_amdgcn_rcpf(1.0f + __builtin_amdgcn_exp2f(-1.4426950409f * x)); }
__device__ __forceinline__ float silu_f(float x) { return x * fast_sigmoid(x); }
__device__ __forceinline__ float gelu_tanh_f(float x) { const float u = 0.7978845608f * (x + 0.044715f * x * x * x); return x * fast_sigmoid(2.0f * u); }

namespace pg8 {
constexpr int BM = 256, BK = 64, HALF = 128, HTB = HALF * BK * 2, STAGE_BYTES = 8 * HTB, NXCD = 8, WGM = 8;
__host__ __device__ __forceinline__ int lds_byte(int r, int c) { const int st = (r >> 4) * 2 + (c >> 5), rr = r & 15, cc = c & 31, ob = rr * 64 + cc * 2; return st * 1024 + (ob ^ (((ob >> 9) & 1) << 5)); }
__host__ __device__ __forceinline__ void stage_rc(int b, int& R, int& C) { const int st = b / 1024, sb = b % 1024, swz = sb ^ (((sb >> 9) & 1) << 5); R = (st >> 1) * 16 + swz / 64; C = (st & 1) * 32 + (swz % 64) / 2; }
__host__ __device__ __forceinline__ int perm32(int rho) { const int n = rho >> 4, i = rho & 15; return 8 * (i >> 2) + 4 * n + (i & 3); }

struct Unit { int b, pm, pn; };
struct Gemm { const char* A; const char* Bt; size_t a_batch, b_batch; unsigned a_rs, a_gs; int K; };

struct BOrder {
    int nM, nN, per, nwg, G, c;
    __device__ void init(int nbatch, int nM_, int nN_, int G_, int c_) { nM = nM_; nN = nN_; per = nM * nN; nwg = nbatch * per; G = G_; c = c_; }
    __device__ bool next(int i, Unit& u) const {
        const long L = (long)i * G + c; if (L >= nwg) return false;
        int w = (int)L; { const int q = nwg / NXCD, r = nwg % NXCD, xcd = w % NXCD, off = w / NXCD; w = (xcd < r ? xcd * (q + 1) : r * (q + 1) + (xcd - r) * q) + off; }
        const int b = w / per, rr = w - b * per;
        const int nig = WGM * nN, gid = rr / nig, fm = gid * WGM, gsz = (nM - fm) < WGM ? (nM - fm) : WGM;
        u.b = b; u.pm = fm + ((rr % nig) % gsz); u.pn = (rr % nig) / gsz; return true;
    }
};

template <class Epi, class Sched>
__device__ __forceinline__ void gemm_phase(LAS unsigned char* lds, const Gemm g, const Sched& S, const Epi& E) {
    int tid_ = threadIdx.x; asm volatile("" : "+v"(tid_));
    const int tid = tid_, wid = __builtin_amdgcn_readfirstlane(tid >> 6), lane = tid & 63, wr = wid >> 2, wc = wid & 3, fr = lane & 15, fq = lane >> 4;
    const int K = g.K, nt = K / BK;
    unsigned voffA[2], voffB[2];
#pragma unroll
    for (int i = 0; i < 2; ++i) { int R, C; stage_rc(tid * 16 + i * 8192, R, C); const int Rb = Epi::PERM ? ((R & ~31) + perm32(R & 31)) : R;
        voffA[i] = (unsigned)R * g.a_rs + (unsigned)(C >> 4) * g.a_gs + (unsigned)(C & 15) * 2u; voffB[i] = (unsigned)(Rb * K + C) * 2u; }
    const size_t kstepA = (size_t)4 * g.a_gs, hstepA = (size_t)HALF * g.a_rs, tstepA = 2 * hstepA;
    const size_t kstepB = (size_t)(BK * 2), hstepB = (size_t)HALF * K * 2, tstepB = 2 * hstepB;
    const unsigned ldsw = (unsigned)wid * 1024u;
    const int aoff = lds_byte(wr * 64 + fr, fq * 8), boff = lds_byte(wc * 32 + fr, fq * 8);
#define PG8_SA(b, h) (((b) * 2 + (h)) * HTB)
#define PG8_SB(b, h) ((4 + (b) * 2 + (h)) * HTB)
#define PG8_STAGE(bufoff, gbase, voff) do { _Pragma("unroll") for (int _i = 0; _i < 2; ++_i) \
        __builtin_amdgcn_global_load_lds((const unsigned*)((const char*)(gbase) + (voff)[_i]), (LAS unsigned*)(lds + (bufoff) + ldsw + _i * 8192), 16, 0, 0); } while (0)
#define PG8_LDA(dst, b, h) do { _Pragma("unroll") for (int m = 0; m < 4; ++m) _Pragma("unroll") for (int k = 0; k < 2; ++k) dst[m][k] = *(const LAS bf16x8*)(lds + PG8_SA(b, h) + aoff + m * 2048 + k * 1024); } while (0)
#define PG8_LDB(dst, b, h) do { _Pragma("unroll") for (int n = 0; n < 2; ++n) _Pragma("unroll") for (int k = 0; k < 2; ++k) dst[n][k] = *(const LAS bf16x8*)(lds + PG8_SB(b, h) + boff + n * 2048 + k * 1024); } while (0)
#define PG8_MMA(ai, bj, At, Bt) do { __builtin_amdgcn_s_setprio(1); _Pragma("unroll") for (int m = 0; m < 4; ++m) _Pragma("unroll") for (int n = 0; n < 2; ++n) _Pragma("unroll") for (int k = 0; k < 2; ++k) \
        acc[ai][bj][m][n] = __builtin_amdgcn_mfma_f32_16x16x32_bf16(Bt[n][k], At[m][k], acc[ai][bj][m][n], 0, 0, 0); __builtin_amdgcn_s_setprio(0); } while (0)
#define PG8_WAIT_V(n) asm volatile("s_waitcnt vmcnt(" #n ")" ::: "memory")
#define PG8_WAIT_L(n) asm volatile("s_waitcnt lgkmcnt(" #n ")" ::: "memory")
#define PG8_BAR __builtin_amdgcn_s_barrier()
#define PG8_SCHED __builtin_amdgcn_sched_barrier(0)
    Unit cur, nxt; int ui = 0;
    if (!S.next(0, cur)) return;
    f32x4 acc[2][2][4][2];
#pragma unroll
    for (int a = 0; a < 2; ++a)
#pragma unroll
        for (int b = 0; b < 2; ++b)
#pragma unroll
            for (int m = 0; m < 4; ++m)
#pragma unroll
                for (int n = 0; n < 2; ++n) acc[a][b][m][n] = (f32x4){0.f, 0.f, 0.f, 0.f};
    bf16x8 At[4][2], B0[2][2], B1[2][2];
    const char* cA = g.A + (size_t)cur.b * g.a_batch + (size_t)cur.pm * tstepA; const char* cB = g.Bt + (size_t)cur.b * g.b_batch + (size_t)cur.pn * tstepB;
    PG8_STAGE(PG8_SB(0, 0), cB, voffB); PG8_STAGE(PG8_SB(0, 1), cB + hstepB, voffB); PG8_STAGE(PG8_SA(0, 0), cA, voffA); PG8_STAGE(PG8_SA(0, 1), cA + hstepA, voffA);
    if (wr == 1) PG8_BAR;
    PG8_WAIT_V(2); PG8_BAR;
    PG8_STAGE(PG8_SB(1, 0), cB + kstepB, voffB); PG8_STAGE(PG8_SA(1, 0), cA + kstepA, voffA); PG8_STAGE(PG8_SB(1, 1), cB + hstepB + kstepB, voffB);
    PG8_WAIT_V(6); PG8_BAR;
    for (;;) {
        const bool has_next = S.next(ui + 1, nxt);
        const char* nA = has_next ? g.A + (size_t)nxt.b * g.a_batch + (size_t)nxt.pm * tstepA : cA; const char* nB = has_next ? g.Bt + (size_t)nxt.b * g.b_batch + (size_t)nxt.pn * tstepB : cB;
        for (int t = 0; t < nt; t += 2) {
            const bool last = (t == nt - 2);
            const char* a1 = cA + (size_t)(t + 1) * kstepA;
            const char* a2 = last ? nA : cA + (size_t)(t + 2) * kstepA; const char* b2 = last ? nB : cB + (size_t)(t + 2) * kstepB;
            const char* a3 = a2 + kstepA; const char* b3 = b2 + kstepB;
            PG8_LDB(B0, 0, 0); PG8_LDB(B1, 0, 1); PG8_SCHED; PG8_LDA(At, 0, 0); PG8_STAGE(PG8_SA(1, 1), a1 + hstepA, voffA);
            PG8_WAIT_V(8); PG8_WAIT_L(0); PG8_BAR; PG8_MMA(0, 0, At, B0); PG8_MMA(0, 1, At, B1); PG8_BAR; PG8_SCHED;
            PG8_LDA(At, 0, 1); PG8_STAGE(PG8_SB(0, 0), b2, voffB); PG8_STAGE(PG8_SB(0, 1), b2 + hstepB, voffB); PG8_STAGE(PG8_SA(0, 0), a2, voffA);
            PG8_WAIT_V(8); PG8_WAIT_L(0); PG8_BAR; PG8_MMA(1, 0, At, B0); PG8_MMA(1, 1, At, B1); PG8_BAR; PG8_SCHED;
            PG8_LDB(B0, 1, 0); PG8_LDB(B1, 1, 1); PG8_SCHED; PG8_LDA(At, 1, 0); PG8_STAGE(PG8_SA(0, 1), a2 + hstepA, voffA);
            PG8_WAIT_V(8); PG8_WAIT_L(0); PG8_BAR; PG8_MMA(0, 0, At, B0); PG8_MMA(0, 1, At, B1); PG8_BAR; PG8_SCHED;
            PG8_LDA(At, 1, 1); PG8_STAGE(PG8_SB(1, 0), b3, voffB); PG8_STAGE(PG8_SB(1, 1), b3 + hstepB, voffB); PG8_STAGE(PG8_SA(1, 0), a3, voffA);
            PG8_WAIT_V(8); PG8_WAIT_L(0); PG8_BAR; PG8_MMA(1, 0, At, B0); PG8_MMA(1, 1, At, B1); PG8_BAR; PG8_SCHED;
        }
        if (wr == 0) PG8_BAR;
        E(acc, cur, wr, wc, fr, fq);
        if (!has_next) break;
#pragma unroll
        for (int a = 0; a < 2; ++a)
#pragma unroll
            for (int b = 0; b < 2; ++b)
#pragma unroll
                for (int m = 0; m < 4; ++m)
#pragma unroll
                    for (int n = 0; n < 2; ++n) acc[a][b][m][n] = (f32x4){0.f, 0.f, 0.f, 0.f};
        cur = nxt; cA = nA; cB = nB; ++ui;
        if (wr == 1) PG8_BAR;
    }
    PG8_WAIT_V(0);
    PG8_BAR;
#undef PG8_SA
#undef PG8_SB
#undef PG8_STAGE
#undef PG8_LDA
#undef PG8_LDB
#undef PG8_MMA
#undef PG8_WAIT_V
#undef PG8_WAIT_L
#undef PG8_BAR
#undef PG8_SCHED
}
}

struct EpiA {
    static constexpr bool PERM = true;
    const float* ssq; bf16* VB; bf16* MG; bf16* UX;
    __device__ __forceinline__ void operator()(const f32x4 (&acc)[2][2][4][2], const pg8::Unit& u, int wr, int wc, int fr, int fq) const {
        const int row0 = u.pm * 256 + wr * 64 + fr;
        float inv[2][4];
#pragma unroll
        for (int ai = 0; ai < 2; ++ai)
#pragma unroll
            for (int m = 0; m < 4; ++m) inv[ai][m] = ssq[row0 + ai * 128 + m * 16];
#pragma unroll
        for (int ai = 0; ai < 2; ++ai)
#pragma unroll
            for (int m = 0; m < 4; ++m) inv[ai][m] = __builtin_amdgcn_rsqf(inv[ai][m] * (1.0f / DM) + EPS);
        const int seg = u.pn >> 2;
        const int cseg = (u.pn & 3) * 256 + wc * 32 + 8 * fq;
        if (seg == 2) {
#pragma unroll
            for (int ai = 0; ai < 2; ++ai)
#pragma unroll
                for (int m = 0; m < 4; ++m) { const int r = row0 + ai * 128 + m * 16; const float sc = inv[ai][m];
#pragma unroll
                    for (int bj = 0; bj < 2; ++bj) { const int c = cseg + bj * 128; const f32x4 v0 = acc[ai][bj][m][0] * sc, v1 = acc[ai][bj][m][1] * sc;
                        u32x4 w; w.x = cvt_pk_bf16(v0[0], v0[1]); w.y = cvt_pk_bf16(v0[2], v0[3]); w.z = cvt_pk_bf16(v1[0], v1[1]); w.w = cvt_pk_bf16(v1[2], v1[3]);
                        bf16* p = UX + ((size_t)(c >> 4) * NCH + (r >> 5)) * UXW + (r & 31) * 16 + (c & 15);
                        *(u32x4*)p = w; } }
        } else {
            bf16* base = (seg == 0) ? VB : (seg == 1 ? MG : MG + 1024); const int rs = (seg == 0) ? 1024 : 2048; const bool act = (seg != 0);
#pragma unroll
            for (int ai = 0; ai < 2; ++ai)
#pragma unroll
                for (int m = 0; m < 4; ++m) { const int r = row0 + ai * 128 + m * 16; const float sc = inv[ai][m];
#pragma unroll
                    for (int bj = 0; bj < 2; ++bj) { const int c = cseg + bj * 128; f32x4 v0 = acc[ai][bj][m][0] * sc, v1 = acc[ai][bj][m][1] * sc;
                        if (act) {
#pragma unroll
                            for (int e = 0; e < 4; ++e) { v0[e] = silu_f(v0[e]); v1[e] = silu_f(v1[e]); } }
                        u32x4 w; w.x = cvt_pk_bf16(v0[0], v0[1]); w.y = cvt_pk_bf16(v0[2], v0[3]); w.z = cvt_pk_bf16(v1[0], v1[1]); w.w = cvt_pk_bf16(v1[2], v1[3]);
                        *(u32x4*)(base + (size_t)r * rs + c) = w; } }
        }
    }
};
struct EpiS {
    static constexpr bool PERM = false;
    float* S;
    __device__ __forceinline__ void operator()(const f32x4 (&acc)[2][2][4][2], const pg8::Unit& u, int wr, int wc, int fr, int fq) const {
        const int row0 = u.pm * 256 + wr * 64 + fr, col0 = wc * 32 + 4 * fq;
#pragma unroll
        for (int ai = 0; ai < 2; ++ai)
#pragma unroll
            for (int m = 0; m < 4; ++m) { float* rowp = S + ((size_t)u.b * NCH + row0 + ai * 128 + m * 16) * 256 + col0;
#pragma unroll
                for (int bj = 0; bj < 2; ++bj)
#pragma unroll
                    for (int n = 0; n < 2; ++n) *(f32x4*)(rowp + bj * 128 + n * 16) = acc[ai][bj][m][n]; }
    }
};
struct EpiY {
    static constexpr bool PERM = true;
    bf16* YG;
    __device__ __forceinline__ void operator()(const f32x4 (&acc)[2][2][4][2], const pg8::Unit& u, int wr, int wc, int fr, int fq) const {
        const int row0 = u.pm * 256 + wr * 64 + fr, col0 = u.pn * 256 + wc * 32 + 8 * fq;
#pragma unroll
        for (int ai = 0; ai < 2; ++ai)
#pragma unroll
            for (int m = 0; m < 4; ++m) { bf16* rowp = YG + ((size_t)u.b * NCH + row0 + ai * 128 + m * 16) * 512 + col0;
#pragma unroll
                for (int bj = 0; bj < 2; ++bj) { f32x4 v0 = acc[ai][bj][m][0], v1 = acc[ai][bj][m][1];
#pragma unroll
                    for (int e = 0; e < 4; ++e) { v0[e] = gelu_tanh_f(v0[e]); v1[e] = gelu_tanh_f(v1[e]); }
                    u32x4 w; w.x = cvt_pk_bf16(v0[0], v0[1]); w.y = cvt_pk_bf16(v0[2], v0[3]); w.z = cvt_pk_bf16(v1[0], v1[1]); w.w = cvt_pk_bf16(v1[2], v1[3]);
                    *(u32x4*)(rowp + bj * 128) = w; } }
    }
};
struct EpiGlu {
    static constexpr bool PERM = false;
    bf16* MG; const float* b1; const float* b2;
    __device__ __forceinline__ void operator()(const f32x4 (&acc)[2][2][4][2], const pg8::Unit& u, int wr, int wc, int fr, int fq) const {
        const int row0 = u.pm * 256 + wr * 64 + fr, cb = u.pn * 128 + wc * 16 + 4 * fq;
        f32x4 B1[2], B2[2];
#pragma unroll
        for (int bj = 0; bj < 2; ++bj) { B1[bj] = *(const f32x4*)(b1 + cb + bj * 64); B2[bj] = *(const f32x4*)(b2 + cb + bj * 64); }
#pragma unroll
        for (int ai = 0; ai < 2; ++ai)
#pragma unroll
            for (int m = 0; m < 4; ++m) { bf16* rowp = MG + (size_t)(row0 + ai * 128 + m * 16) * 2048 + 1024 + cb;
#pragma unroll
                for (int bj = 0; bj < 2; ++bj) { const u32x2 sg = *(const u32x2*)(rowp + bj * 64);
                    const f32x4 a = acc[ai][bj][m][0] + B1[bj], b = acc[ai][bj][m][1] + B2[bj];
                    const float o0 = a[0] * fast_sigmoid(b[0]) * bf_lo(sg.x), o1 = a[1] * fast_sigmoid(b[1]) * bf_hi(sg.x);
                    const float o2 = a[2] * fast_sigmoid(b[2]) * bf_lo(sg.y), o3 = a[3] * fast_sigmoid(b[3]) * bf_hi(sg.y);
                    u32x2 w; w.x = cvt_pk_bf16(o0, o1); w.y = cvt_pk_bf16(o2, o3);
                    *(u32x2*)(rowp + bj * 64) = w; } }
    }
};
struct EpiOut {
    static constexpr bool PERM = false;
    const float* base_p; const float* base_s; float* out; bf16* xb; float* ssq;
    __device__ __forceinline__ void operator()(const f32x4 (&acc)[2][2][4][2], const pg8::Unit& u, int wr, int wc, int fr, int fq) const {
        const int row0 = u.pm * 256 + wr * 64 + fr, col0 = u.pn * 256 + wc * 32 + 4 * fq;
        const float* bb = (u.pm < TP / 256) ? base_p : base_s - (size_t)TP * DM;
#pragma unroll
        for (int ai = 0; ai < 2; ++ai)
#pragma unroll
            for (int m = 0; m < 4; ++m) { const int r = row0 + ai * 128 + m * 16; const size_t off = (size_t)r * DM + col0; float s = 0.f;
#pragma unroll
                for (int bj = 0; bj < 2; ++bj)
#pragma unroll
                    for (int n = 0; n < 2; ++n) { const f32x4 bs = *(const f32x4*)(bb + off + bj * 128 + n * 16); const f32x4 o = bs + acc[ai][bj][m][n];
                        *(f32x4*)(out + off + bj * 128 + n * 16) = o; s += (o[0] * o[0] + o[1] * o[1]) + (o[2] * o[2] + o[3] * o[3]);
                        if (xb) { u32x2 w; w.x = cvt_pk_bf16(o[0], o[1]); w.y = cvt_pk_bf16(o[2], o[3]); *(u32x2*)(xb + off + bj * 128 + n * 16) = w; } }
                s += __shfl_xor(s, 16); s += __shfl_xor(s, 32);
                if (fq == 0) atomicAdd(ssq + r, s);
                if (m & 1) asm volatile("" ::: "memory"); }
    }
};

#define XB_TMO      128
#define XB_XCNT(j)  (256  + 64 * (j))
#define XB_XSUB(j)  (1280 + 64 * (j))
#define XB_XGEN(j)  (2304 + 64 * (j))
#define XB_TOP      3328
#define XB_TOPGEN   3392
#define XCD_BAR_WORDS 3456
#define XB_SPIN_CAP (1u << 18)
__device__ __forceinline__ unsigned xb_ld(unsigned* p)              { return __hip_atomic_load(p, __ATOMIC_RELAXED, __HIP_MEMORY_SCOPE_AGENT); }
__device__ __forceinline__ unsigned xb_add(unsigned* p, unsigned v) { return __hip_atomic_fetch_add(p, v, __ATOMIC_RELAXED, __HIP_MEMORY_SCOPE_AGENT); }
__device__ __forceinline__ unsigned xb_xcc_id() { return (unsigned)__builtin_amdgcn_s_getreg((3 << 11) | 20) & 0xFu; }
#define XB_SPIN(cond, bar) do { unsigned _sp = 0; while (cond) { __builtin_amdgcn_s_sleep(1); \
    if ((++_sp & 255u) == 0u) { if (xb_ld(&(bar)[XB_TMO])) break; if (_sp > XB_SPIN_CAP) { atomicAdd(&(bar)[XB_TMO], 1u); break; } } } } while (0)
struct XcdBarrier { unsigned* bar; unsigned x; volatile LAS unsigned* st; };
__device__ __forceinline__ XcdBarrier xcd_barrier_post(unsigned* bar, volatile LAS unsigned* st) {
    XcdBarrier b; b.bar = bar; b.x = xb_xcc_id(); b.st = st;
    if (threadIdx.x == 0) (void)xb_add(&bar[XB_XCNT(b.x)], 1u);
    return b;
}
__device__ __forceinline__ void xcd_barrier_complete(unsigned* bar, unsigned x, unsigned& nloc, unsigned& nx) {
    const unsigned G = gridDim.x * gridDim.y * gridDim.z;
    unsigned sum, cnt, mine, sp = 0u;
    for (;;) {
        sum = 0u; cnt = 0u; mine = 0u;
#pragma unroll
        for (unsigned j = 0; j < 16; ++j) { const unsigned c = xb_ld(&bar[XB_XCNT(j)]); sum += c; cnt += (c > 0u) ? 1u : 0u; mine = (j == x) ? c : mine; }
        if (sum == G) break;
        __builtin_amdgcn_s_sleep(1);
        if ((++sp & 255u) == 0u) { if (xb_ld(&bar[XB_TMO])) break; if (sp > XB_SPIN_CAP) { atomicAdd(&bar[XB_TMO], 1u); break; } }
    }
    nloc = mine > 0u ? mine : 1u; nx = cnt > 0u ? cnt : 1u;
}
__device__ __forceinline__ void xcd_barrier(const XcdBarrier& b) {
    asm volatile("s_waitcnt vmcnt(0)" ::: "memory");
    __syncthreads();
    if (threadIdx.x == 0) {
        unsigned* bar = b.bar; asm volatile("" : "+s"(bar));
        __builtin_amdgcn_s_waitcnt(0);
        unsigned nloc = b.st[0], nx = b.st[1];
        if (nloc == 0u) { xcd_barrier_complete(bar, b.x, nloc, nx); b.st[0] = nloc; b.st[1] = nx; }
        const unsigned old = xb_add(&bar[XB_XSUB(b.x)], 1u);
        const unsigned gen = old / nloc;
        if (old + 1u == (gen + 1u) * nloc) {
            __builtin_amdgcn_fence(__ATOMIC_RELEASE, "agent");
            asm volatile("s_waitcnt vmcnt(0)" ::: "memory");
            const unsigned og = xb_add(&bar[XB_TOP], 1u);
            const unsigned tg = og / nx;
            if (og + 1u == (tg + 1u) * nx) xb_add(&bar[XB_TOPGEN], 1u);
            else XB_SPIN(xb_ld(&bar[XB_TOPGEN]) == tg, bar);
            __builtin_amdgcn_fence(__ATOMIC_ACQUIRE, "agent");
            xb_add(&bar[XB_XGEN(b.x)], 1u);
            asm volatile("s_waitcnt vmcnt(0)" ::: "memory");
        } else {
            XB_SPIN(xb_ld(&bar[XB_XGEN(b.x)]) == gen, bar);
            __builtin_amdgcn_fence(__ATOMIC_ACQUIRE, "agent");
            asm volatile("s_waitcnt vmcnt(0)" ::: "memory");
        }
    }
    __syncthreads();
}

struct Args {
    const float* xp; const float* xs; const float* norm_g; const float* w_in; const float* pool_w; const float* pool_scale;
    const float* lam_re; const float* lam_im; const float* log_step; const float* b_re; const float* b_im; const float* c_re; const float* c_im;
    const float* d_skip; const float* glu_w1; const float* glu_b1; const float* glu_w2; const float* glu_b2; const float* w_out; const float* final_g;
    float* out; unsigned char* ws;
};

__device__ __forceinline__ f32x2 cmul(f32x2 a, f32x2 b) { return (f32x2){a.x * b.x - a.y * b.y, a.x * b.y + a.y * b.x}; }
__device__ __forceinline__ f32x2 cexp_pow(float lr, float li, float st, float n) {
    const float mag = __builtin_amdgcn_exp2f(lr * st * n * 1.4426950409f);
    const double q4 = (double)li * (double)st * (double)n * 0.63661977236758134308;
    const double kq = __builtin_rint(q4);
    const float y = (float)((q4 - kq) * 1.57079632679489661923);
    const int q = (int)((long long)kq & 3ll);
    const float y2 = y * y;
    const float sn = y + y * y2 * (-1.6666667163e-1f + y2 * (8.3333337680e-3f + y2 * (-1.9841270114e-4f + y2 * 2.7557314297e-6f)));
    const float cs = 1.0f + y2 * (-0.5f + y2 * (4.1666667908e-2f + y2 * (-1.3888889225e-3f + y2 * (2.4801587642e-5f + y2 * -2.7557314297e-7f))));
    float c, s;
    if (q == 0) { c = cs; s = sn; } else if (q == 1) { c = -sn; s = cs; } else if (q == 2) { c = -cs; s = -sn; } else { c = sn; s = -cs; }
    return (f32x2){mag * c, mag * s};
}

template <class RowMap>
__device__ __forceinline__ void transpose_item(const float* W, int ldn, int K, int k0, int n0, bf16* WT, RowMap rm, const float* kscale, LAS float* scr, int lane) {
#pragma unroll 8
    for (int i = 0; i < 32; ++i) { const int kk = 2 * i + (lane >> 5); float v = W[(size_t)(k0 + kk) * ldn + n0 + (lane & 31)]; if (kscale) v *= kscale[k0 + kk]; scr[kk * 33 + (lane & 31)] = v; }
    LDS_WAIT(); asm volatile("" ::: "memory");
    const int c = lane & 7;
#pragma unroll
    for (int j = 0; j < 4; ++j) { const int n = (lane >> 3) + 8 * j; const LAS float* s = scr + (8 * c) * 33 + n;
        u32x4 o; o.x = cvt_pk_bf16(s[0 * 33], s[1 * 33]); o.y = cvt_pk_bf16(s[2 * 33], s[3 * 33]); o.z = cvt_pk_bf16(s[4 * 33], s[5 * 33]); o.w = cvt_pk_bf16(s[6 * 33], s[7 * 33]);
        *(u32x4*)(WT + (size_t)rm(n0 + n) * K + k0 + 8 * c) = o; }
    LDS_WAIT(); asm volatile("" ::: "memory");
}
struct RowId { int off; __device__ __forceinline__ int operator()(int n) const { return n + off; } };
struct RowGlu { int which; __device__ __forceinline__ int operator()(int n) const { return 32 * (n >> 4) + 16 * which + (n & 15); } };

__device__ __forceinline__ void p0_ssm_item(const Args& a, LAS unsigned char* lds, int l, int g, int half, int tid) {
    LAS f32x2* AP = (LAS f32x2*)lds;
    LAS f32x2* BB = (LAS f32x2*)(lds + 33792);
    LAS f32x2* CC = (LAS f32x2*)(lds + 50176);
    LAS float* KK = (LAS float*)(lds + 66560);
    for (int idx = tid; idx < 2 * 64 * 33; idx += 512) { const int d = idx / (64 * 33), rem = idx - d * 64 * 33, p = rem / 33, tau = rem - p * 33;
        const int li = ((l * 2 + d) * 64 + g) * 64 + p; const float st = expf(a.log_step[(l * 2 + d) * 64 + g]);
        AP[idx] = cexp_pow(a.lam_re[li], a.lam_im[li], st, (float)tau); }
    for (int idx = tid; idx < 2 * 64 * 16; idx += 512) { const int d = idx >> 10, p = (idx >> 4) & 63, h = idx & 15;
        const int li = ((l * 2 + d) * 64 + g) * 64 + p; const float lr = a.lam_re[li], lim = a.lam_im[li], st = expf(a.log_step[(l * 2 + d) * 64 + g]);
        const f32x2 a1 = cexp_pow(lr, lim, st, 1.0f); const float nr = a1.x - 1.0f, ni = a1.y, den = 1.0f / (lr * lr + lim * lim);
        const f32x2 coef = (f32x2){(nr * lr + ni * lim) * den, (ni * lr - nr * lim) * den};
        const size_t bi = ((size_t)li) * 16 + h;
        BB[idx] = cmul(coef, (f32x2){a.b_re[bi], a.b_im[bi]});
        const size_t ci = ((size_t)((l * 2 + d) * 64 + g) * 16 + h) * 64 + p;
        CC[idx] = (f32x2){a.c_re[ci], a.c_im[ci]}; }
    __syncthreads();
#pragma unroll 1
    for (int j = 0; j < 2; ++j) { const int q = tid + 512 * j, h = q & 15, tau = (q >> 4) & 31, d = q >> 9;
        float ac[16];
#pragma unroll
        for (int e = 0; e < 16; ++e) ac[e] = 0.f;
        for (int p = 0; p < 64; ++p) { const f32x2 m = cmul(CC[(d * 64 + p) * 16 + h], AP[(d * 64 + p) * 33 + tau]);
#pragma unroll
            for (int e = 0; e < 16; ++e) { const f32x2 b = BB[(d * 64 + p) * 16 + e]; ac[e] += m.x * b.x - m.y * b.y; } }
#pragma unroll
        for (int e = 0; e < 16; ++e) KK[((d * 32 + tau) * 16 + h) * 16 + e] = ac[e]; }
    __syncthreads();
    { const int d = half; bf16* W1 = (bf16*)(a.ws + WS_W1OP) + ((size_t)(l * NG + g) * 256 + d * 128) * 512;
      for (int idx = tid; idx < 128 * 64; idx += 512) { const int rr = idx >> 6, j = idx & 63, p = rr >> 1, ri = rr & 1, s = j >> 1, h0 = (j & 1) * 8;
          const f32x2 pw = AP[(d * 64 + p) * 33 + (d == 0 ? (QC - 1 - s) : s)]; float v[8];
#pragma unroll
          for (int e = 0; e < 8; ++e) { const f32x2 m = cmul(pw, BB[(d * 64 + p) * 16 + h0 + e]); v[e] = ri ? m.y : m.x; }
          u32x4 o; o.x = cvt_pk_bf16(v[0], v[1]); o.y = cvt_pk_bf16(v[2], v[3]); o.z = cvt_pk_bf16(v[4], v[5]); o.w = cvt_pk_bf16(v[6], v[7]);
          *(u32x4*)(W1 + (size_t)rr * 512 + j * 8) = o; } }
    { bf16* TW = (bf16*)(a.ws + WS_TW) + (size_t)(l * NG + g) * 512 * UXW;
      for (int idx = tid; idx < 256 * 96; idx += 512) { const int rr = idx / 96, j = idx - rr * 96, t = 16 * half + (rr >> 4), h = rr & 15; float v[8];
          if (j < 64) { const int s = j >> 1, h0 = (j & 1) * 8;
              if (t > s) {
#pragma unroll
                  for (int e = 0; e < 8; ++e) v[e] = KK[((0 * 32 + (t - s)) * 16 + h) * 16 + h0 + e];
              } else if (t < s) {
#pragma unroll
                  for (int e = 0; e < 8; ++e) v[e] = KK[((1 * 32 + (s - t)) * 16 + h) * 16 + h0 + e];
              } else { const float dsk = a.d_skip[l * 1024 + g * 16 + h];
#pragma unroll
                  for (int e = 0; e < 8; ++e) v[e] = KK[((0 * 32) * 16 + h) * 16 + h0 + e] + KK[((1 * 32) * 16 + h) * 16 + h0 + e] + ((h0 + e == h) ? dsk : 0.f); }
          } else { const int xi = (j - 64) * 8, d = xi >> 7, p0 = (xi & 127) >> 1; const int ex = (d == 0) ? (t + 1) : (QC - t);
#pragma unroll
              for (int e = 0; e < 4; ++e) { const f32x2 m = cmul(CC[(d * 64 + p0 + e) * 16 + h], AP[(d * 64 + p0 + e) * 33 + ex]); v[2 * e] = m.x; v[2 * e + 1] = -m.y; } }
          u32x4 o; o.x = cvt_pk_bf16(v[0], v[1]); o.y = cvt_pk_bf16(v[2], v[3]); o.z = cvt_pk_bf16(v[4], v[5]); o.w = cvt_pk_bf16(v[6], v[7]);
          *(u32x4*)(TW + (size_t)(t * 16 + h) * UXW + j * 8) = o; } }
    __syncthreads();
}
__device__ __forceinline__ void p0_fold_item(const Args& a, LAS unsigned char* lds, int l, int gq, int kb, int tid) {
    LAS float* Wl = (LAS float*)lds;
    constexpr int LD = 260;
    for (int idx = tid; idx < 64 * 64; idx += 512) { const int kk = idx >> 6, c4 = (idx & 63) * 4;
        const f32x4 w = *(const f32x4*)(a.w_in + ((size_t)(l * 1024 + kb * 64 + kk)) * NCOL + gq * 256 + c4);
        *(LAS f32x4*)(Wl + kk * LD + c4) = w; }
    __syncthreads();
    const int d = tid & 255, kh = tid >> 8;
    float ac[32];
#pragma unroll
    for (int e = 0; e < 32; ++e) ac[e] = 0.f;
    const float* pw = a.pool_w + ((size_t)(l * 4 + gq) * 256) * 256 + d;
    for (int c = 0; c < 256; c += 4) { const float p0 = pw[(size_t)c * 256], p1 = pw[(size_t)(c + 1) * 256], p2 = pw[(size_t)(c + 2) * 256], p3 = pw[(size_t)(c + 3) * 256];
#pragma unroll
        for (int e = 0; e < 32; ++e) { const f32x4 w = *(const LAS f32x4*)(Wl + (kh * 32 + e) * LD + c); ac[e] += (w[0] * p0 + w[1] * p1) + (w[2] * p2 + w[3] * p3); } }
    const float sc = a.pool_scale[l * 1024 + gq * 256 + d];
    bf16* o = (bf16*)(a.ws + WS_BT1) + ((size_t)l * NCOL + gq * 256 + d) * DM + kb * 64 + kh * 32;
    const float* ng = a.norm_g + l * 1024 + kb * 64 + kh * 32;
#pragma unroll
    for (int e = 0; e < 32; e += 8) { u32x4 w; w.x = cvt_pk_bf16(ac[e] * sc * ng[e], ac[e + 1] * sc * ng[e + 1]); w.y = cvt_pk_bf16(ac[e + 2] * sc * ng[e + 2], ac[e + 3] * sc * ng[e + 3]);
        w.z = cvt_pk_bf16(ac[e + 4] * sc * ng[e + 4], ac[e + 5] * sc * ng[e + 5]); w.w = cvt_pk_bf16(ac[e + 6] * sc * ng[e + 6], ac[e + 7] * sc * ng[e + 7]); *(u32x4*)(o + e) = w; }
    __syncthreads();
}
__device__ __forceinline__ float wave_sum(float v) {
#pragma unroll
    for (int o = 1; o < 64; o <<= 1) v += __shfl_xor(v, o);
    return v;
}

__device__ __forceinline__ void scan_item(const Args& a, LAS unsigned char* lds, int l, int g, int d, int oct, int wave, int lane) {
    const float* S = (const float*)(a.ws + WS_R1) + (size_t)g * NCH * 256 + d * 128 + 2 * lane;
    bf16* UX = (bf16*)(a.ws + WS_UX) + (size_t)g * NCH * UXW + 512 + d * 128 + 2 * lane;
    const int li = ((l * 2 + d) * 64 + g) * 64 + lane; const float lr = a.lam_re[li], lim = a.lam_im[li], st = expf(a.log_step[(l * 2 + d) * 64 + g]);
    const f32x2 aQ = cexp_pow(lr, lim, st, (float)QC);
    const int c0 = (oct < 2) ? (oct * 8 + wave) * 64 : 1024 + wave * 64;
    f32x2 X = (f32x2){0.f, 0.f};
    if (oct == 2) {
        f32x2 F = (f32x2){0.f, 0.f};
#pragma unroll 1
        for (int cb = 0; cb < 4; ++cb) { f32x2 sv[16];
#pragma unroll
            for (int i = 0; i < 16; ++i) { const int k = cb * 16 + i; const int c = (d == 0) ? (c0 + k) : (c0 + 63 - k); sv[i] = *(const f32x2*)(S + (size_t)c * 256); }
#pragma unroll
            for (int i = 0; i < 16; ++i) { F = cmul(aQ, F) + sv[i]; } }
        LAS f32x2* FL = (LAS f32x2*)lds;
        FL[wave * 64 + lane] = F;
        __syncthreads();
        const f32x2 A64 = cexp_pow(lr, lim, st, (float)(QC * 64));
        if (d == 0) { for (int w = 0; w < wave; ++w) X = cmul(A64, X) + FL[w * 64 + lane]; }
        else { for (int w = 7; w > wave; --w) X = cmul(A64, X) + FL[w * 64 + lane]; }
        __syncthreads();
    }
#pragma unroll 1
    for (int cb = 0; cb < 4; ++cb) { f32x2 sv[16];
#pragma unroll
        for (int i = 0; i < 16; ++i) { const int k = cb * 16 + i; const int c = (d == 0) ? (c0 + k) : (c0 + 63 - k); sv[i] = *(const f32x2*)(S + (size_t)c * 256); }
#pragma unroll
        for (int i = 0; i < 16; ++i) { const int k = cb * 16 + i; const int c = (d == 0) ? (c0 + k) : (c0 + 63 - k);
            *(unsigned*)(UX + (size_t)c * UXW) = cvt_pk_bf16(X.x, X.y);
            X = cmul(aQ, X) + sv[i]; } }
}
__device__ __forceinline__ void pool_item(const Args& a, int rb, int gq, int lane) {
    const bf16* VB = (const bf16*)(a.ws + WS_R2) + gq * 256 + 4 * lane;
    bf16* MG = (bf16*)(a.ws + WS_MG) + gq * 256 + 4 * lane;
    const int half = 1 << gq;
    const int t0 = rb * 128;
    const int ss = (t0 < TP) ? (t0 & ~2047) : TP, se = (t0 < TP) ? ss + 2048 : T;
    float w0 = 0.f, w1 = 0.f, w2 = 0.f, w3 = 0.f;
    { const int lo = max(t0 - half, ss), hi = min(t0 + half, se);
      for (int j = lo; j < hi; ++j) { const u32x2 v = *(const u32x2*)(VB + (size_t)j * 1024); w0 += bf_lo(v.x); w1 += bf_hi(v.x); w2 += bf_lo(v.y); w3 += bf_hi(v.y); } }
#pragma unroll 4
    for (int t = t0; t < t0 + 128; ++t) {
        const int lo = max(t - half, ss), hi = min(t + half, se);
        const float rc = __builtin_amdgcn_rcpf((float)(hi - lo));
        const u32x2 v = *(const u32x2*)(VB + (size_t)t * 1024);
        const u32x2 sg = *(const u32x2*)(MG + (size_t)t * 2048);
        const float o0 = (w0 * rc - bf_lo(v.x)) * bf_lo(sg.x), o1 = (w1 * rc - bf_hi(v.x)) * bf_hi(sg.x);
        const float o2 = (w2 * rc - bf_lo(v.y)) * bf_lo(sg.y), o3 = (w3 * rc - bf_hi(v.y)) * bf_hi(sg.y);
        u32x2 w; w.x = cvt_pk_bf16(o0, o1); w.y = cvt_pk_bf16(o2, o3);
        *(u32x2*)(MG + (size_t)t * 2048) = w;
        if (t + 1 + half <= se) { const u32x2 n = *(const u32x2*)(VB + (size_t)(t + half) * 1024); w0 += bf_lo(n.x); w1 += bf_hi(n.x); w2 += bf_lo(n.y); w3 += bf_hi(n.y); }
        if (t + 1 - half > ss) { const u32x2 o = *(const u32x2*)(VB + (size_t)(t - half) * 1024); w0 -= bf_lo(o.x); w1 -= bf_hi(o.x); w2 -= bf_lo(o.y); w3 -= bf_hi(o.y); }
    }
}

__global__ void __launch_bounds__(NWAVES * 64, 2) mk_fwd(Args args) {
    extern __shared__ __attribute__((aligned(16))) unsigned char lds_raw[];
    LAS unsigned char* lds = (LAS unsigned char*)lds_raw;
    const int tid = threadIdx.x, lane = tid & 63, wave = __builtin_amdgcn_readfirstlane(tid >> 6);
    const int G = gridDim.x, bx = blockIdx.x;
    const int vcu = (G % 8 == 0) ? (bx % 8) * (G / 8) + bx / 8 : bx;
    const int gw = vcu * NWAVES + wave, NGW = G * NWAVES;
    unsigned char* ws = args.ws;
    unsigned* ctl = (unsigned*)(ws + WS_CTL);
    volatile LAS unsigned* MISC = (volatile LAS unsigned*)(lds + MISC_OFF);
    if (tid < 16) MISC[tid] = 0u;
    __syncthreads();
    XcdBarrier bar = xcd_barrier_post(ctl + CW_BAR, MISC);
    cg::grid_group grid = cg::this_grid();

    float* ssq = (float*)(ws + WS_SSQ);
    bf16* BT1 = (bf16*)(ws + WS_BT1); bf16* BTG = (bf16*)(ws + WS_BTG); bf16* BTO = (bf16*)(ws + WS_BTO);
    bf16* XB = (bf16*)(ws + WS_R1); bf16* VB = (bf16*)(ws + WS_R2); bf16* UX = (bf16*)(ws + WS_UX); bf16* MG = (bf16*)(ws + WS_MG);

    {
        for (int it = bx; it < 256; it += G) p0_ssm_item(args, lds, it >> 7, (it >> 1) & 63, it & 1, tid);
        for (int it = bx; it < 128; it += G) p0_fold_item(args, lds, it >> 6, (it >> 4) & 3, it & 15, tid);
        LAS float* scr = (LAS float*)(lds + wave * 16384);
        constexpr int I_IN = 16 * 96, I_GLU = 16 * 32, I_OUT = 32 * 32, PER_L = I_IN + 2 * I_GLU + I_OUT;
        for (int it = gw; it < 2 * PER_L; it += NGW) { const int l = it / PER_L; int r = it - l * PER_L;
            if (r < I_IN) { const int kb = r / 96, nb = r - kb * 96;
                transpose_item(args.w_in + (size_t)l * DM * NCOL, NCOL, DM, kb * 64, 1024 + nb * 32, BT1 + (size_t)l * NCOL * DM, RowId{0}, args.norm_g + l * DM, scr, lane); continue; }
            r -= I_IN;
            if (r < I_GLU) { const int kb = r >> 5, nb = r & 31;
                transpose_item(args.glu_w1 + (size_t)l * DM * DM, DM, DM, kb * 64, nb * 32, BTG + (size_t)l * 2048 * DM, RowGlu{0}, (const float*)nullptr, scr, lane); continue; }
            r -= I_GLU;
            if (r < I_GLU) { const int kb = r >> 5, nb = r & 31;
                transpose_item(args.glu_w2 + (size_t)l * DM * DM, DM, DM, kb * 64, nb * 32, BTG + (size_t)l * 2048 * DM, RowGlu{1}, (const float*)nullptr, scr, lane); continue; }
            r -= I_GLU;
            { const int kb = r >> 5, nb = r & 31;
                transpose_item(args.w_out + (size_t)l * 2048 * DM, DM, 2048, kb * 64, nb * 32, BTO + (size_t)l * DM * 2048, RowId{0}, (const float*)nullptr, scr, lane); }
        }
        for (int m = gw; m < T; m += NGW) { const float* xr = (m < TP) ? args.xp + (size_t)m * DM : args.xs + (size_t)(m - TP) * DM;
            const f32x4* x4 = (const f32x4*)xr + lane; f32x4 v[4]; float s = 0.f;
#pragma unroll
            for (int j = 0; j < 4; ++j) { v[j] = x4[64 * j]; s += (v[j][0] * v[j][0] + v[j][1] * v[j][1]) + (v[j][2] * v[j][2] + v[j][3] * v[j][3]); }
            s = wave_sum(s);
            u32x2* o = (u32x2*)(XB + (size_t)m * DM) + lane;
#pragma unroll
            for (int j = 0; j < 4; ++j) { u32x2 w; w.x = cvt_pk_bf16(v[j][0], v[j][1]); w.y = cvt_pk_bf16(v[j][2], v[j][3]); o[64 * j] = w; }
            if (lane == 0) ssq[m] = s; }
    }
    __threadfence();
    grid.sync();

    for (int l = 0; l < 2; ++l) {
        { pg8::Gemm g{(const char*)XB, (const char*)(BT1 + (size_t)l * NCOL * DM), 0, 0, DM * 2, 32, DM};
          pg8::BOrder S; S.init(1, T / 256, NCOL / 256, G, bx);
          EpiA E{ssq + (size_t)l * T, VB, MG, UX};
          pg8::gemm_phase<EpiA, pg8::BOrder>(lds, g, S, E); }
        xcd_barrier(bar);
        { pg8::Gemm g{(const char*)UX, (const char*)((bf16*)(ws + WS_W1OP) + (size_t)l * NG * 256 * 512), (size_t)NCH * UXW * 2, (size_t)256 * 512 * 2, UXW * 2, 32, 512};
          pg8::BOrder S; S.init(NG, NCH / 256, 1, G, bx);
          EpiS E{(float*)(ws + WS_R1)};
          pg8::gemm_phase<EpiS, pg8::BOrder>(lds, g, S, E); }
        xcd_barrier(bar);
        { int t2 = threadIdx.x; asm volatile("" : "+v"(t2)); const int lane2 = t2 & 63, wave2 = __builtin_amdgcn_readfirstlane(t2 >> 6), gw2 = vcu * NWAVES + wave2;
          for (int it = bx; it < 384; it += G) { scan_item(args, lds, l, it & 63, (it >> 6) & 1, it >> 7, wave2, lane2); }
          for (int it = NGW - 1 - gw2; it < 1536; it += NGW) pool_item(args, it >> 2, it & 3, lane2); }
        xcd_barrier(bar);
        { pg8::Gemm g{(const char*)UX, (const char*)((bf16*)(ws + WS_TW) + (size_t)l * NG * 512 * UXW), (size_t)NCH * UXW * 2, (size_t)512 * UXW * 2, UXW * 2, 32, UXW};
          pg8::BOrder S; S.init(NG, NCH / 256, 2, G, bx);
          EpiY E{(bf16*)(ws + WS_R2)};
          pg8::gemm_phase<EpiY, pg8::BOrder>(lds, g, S, E); }
        xcd_barrier(bar);
        { pg8::Gemm g{(const char*)(ws + WS_R2), (const char*)(BTG + (size_t)l * 2048 * DM), 0, 0, 32, (unsigned)T * 32u, DM};
          pg8::BOrder S; S.init(1, T / 256, 2048 / 256, G, bx);
          EpiGlu E{MG, args.glu_b1 + l * DM, args.glu_b2 + l * DM};
          pg8::gemm_phase<EpiGlu, pg8::BOrder>(lds, g, S, E); }
        xcd_barrier(bar);
        { pg8::Gemm g{(const char*)MG, (const char*)(BTO + (size_t)l * DM * 2048), 0, 0, 2048 * 2, 32, 2048};
          pg8::BOrder S; S.init(1, T / 256, DM / 256, G, bx);
          EpiOut E{l == 0 ? args.xp : args.out, l == 0 ? args.xs : args.out + (size_t)TP * DM, args.out, l == 0 ? XB : (bf16*)nullptr, ssq + (size_t)(l + 1) * T};
          pg8::gemm_phase<EpiOut, pg8::BOrder>(lds, g, S, E); }
        xcd_barrier(bar);
    }
    int t3 = threadIdx.x; asm volatile("" : "+v"(t3)); const int lane3 = t3 & 63, gw3 = vcu * NWAVES + __builtin_amdgcn_readfirstlane(t3 >> 6);
    for (int m = gw3; m < T; m += NGW) { float* xr = args.out + (size_t)m * DM; f32x4* x4 = (f32x4*)xr + lane3; const f32x4* g4 = (const f32x4*)args.final_g + lane3;
        const float inv = __builtin_amdgcn_rsqf(ssq[2 * (size_t)T + m] * (1.0f / DM) + EPS);
#pragma unroll
        for (int j = 0; j < 4; ++j) { const f32x4 v = x4[64 * j], gg = g4[64 * j]; x4[64 * j] = v * inv * gg; } }
}

extern "C" void kernel_launch(void* const* d_in, const int* in_sizes, int n_in, void* d_out, int out_size, void* d_ws, size_t ws_size, hipStream_t stream) {
    static int grid = 0;
    if (grid == 0) {
        if (n_in != 20 || in_sizes[0] != TP * DM || in_sizes[1] != (T - TP) * DM || out_size != T * DM || ws_size < WS_END) {
            fprintf(stderr, "kernel_launch: unexpected shapes (n_in %d, in0 %d, out %d, ws %zu)\n", n_in, n_in > 0 ? in_sizes[0] : -1, out_size, ws_size); grid = -1; return; }
        int dev = 0, cus = 0, per_cu = 0;
        if (hipGetDevice(&dev) != hipSuccess || hipDeviceGetAttribute(&cus, hipDeviceAttributeMultiprocessorCount, dev) != hipSuccess) { grid = -1; return; }
        if (hipFuncSetAttribute((const void*)mk_fwd, hipFuncAttributeMaxDynamicSharedMemorySize, LDS_BYTES) != hipSuccess) { fprintf(stderr, "kernel_launch: hipFuncSetAttribute failed\n"); grid = -1; return; }
        if (hipOccupancyMaxActiveBlocksPerMultiprocessor(&per_cu, (const void*)mk_fwd, NWAVES * 64, LDS_BYTES) != hipSuccess || per_cu < 1) {
            fprintf(stderr, "kernel_launch: occupancy query says %d blocks per CU\n", per_cu); (void)hipGetLastError(); grid = -1; return; }
        grid = cus;
    }
    if (grid < 0) return;
    if (hipMemsetAsync((char*)d_ws + WS_CTL, 0, CTL_ZERO_BYTES, stream) != hipSuccess) { fprintf(stderr, "kernel_launch: memset failed\n"); return; }
    Args a{};
    a.xp = (const float*)d_in[0]; a.xs = (const float*)d_in[1]; a.norm_g = (const float*)d_in[2]; a.w_in = (const float*)d_in[3]; a.pool_w = (const float*)d_in[4]; a.pool_scale = (const float*)d_in[5];
    a.lam_re = (const float*)d_in[6]; a.lam_im = (const float*)d_in[7]; a.log_step = (const float*)d_in[8]; a.b_re = (const float*)d_in[9]; a.b_im = (const float*)d_in[10]; a.c_re = (const float*)d_in[11]; a.c_im = (const float*)d_in[12];
    a.d_skip = (const float*)d_in[13]; a.glu_w1 = (const float*)d_in[14]; a.glu_b1 = (const float*)d_in[15]; a.glu_w2 = (const float*)d_in[16]; a.glu_b2 = (const float*)d_in[17]; a.w_out = (const float*)d_in[18]; a.final_g = (const float*)d_in[19];
    a.out = (float*)d_out; a.ws = (unsigned char*)d_ws;
    void* kargs[] = {&a};
    hipError_t e = hipLaunchCooperativeKernel((const void*)mk_fwd, dim3(grid), dim3(NWAVES * 64), kargs, LDS_BYTES, stream);
    if (e != hipSuccess) fprintf(stderr, "kernel_launch: cooperative launch failed: %s (grid %d)\n", hipGetErrorString(e), grid);
}
```

```cpp
#include <hip/hip_runtime.h>
#include <hip/hip_cooperative_groups.h>
#include <cstdio>
#include <cstdint>
namespace cg = cooperative_groups;

#define LAS __attribute__((address_space(3)))
#define GAS __attribute__((address_space(1)))
typedef unsigned short bf16;
typedef short bf16x8 __attribute__((ext_vector_type(8)));
typedef float f32x4 __attribute__((ext_vector_type(4)));
typedef float f32x2 __attribute__((ext_vector_type(2)));
typedef unsigned u32x4 __attribute__((ext_vector_type(4)));
typedef unsigned u32x2 __attribute__((ext_vector_type(2)));

constexpr int T = 49152;
constexpr int TP = 32768;
constexpr int DM = 1024;
constexpr int NCOL = 4096;
constexpr int QC = 32;
constexpr int NCH = T / QC;
constexpr int NG = 64;
constexpr int UXW = 768;
constexpr int MGS = 2048 + 64;
constexpr float EPS = 1e-6f;

constexpr size_t MiB = 1u << 20;
constexpr size_t WS_CTL = 0, CTL_ZERO_BYTES = 1 * MiB;
constexpr size_t WS_SSQ = 256 * 1024;
constexpr size_t WS_BT1 = 4 * MiB;
constexpr size_t WS_BTG = 20 * MiB;
constexpr size_t WS_BTO = 28 * MiB;
constexpr size_t WS_W1OP = 36 * MiB;
constexpr size_t WS_TW = 68 * MiB;
constexpr size_t WS_R1 = 164 * MiB;
constexpr size_t WS_R2 = 260 * MiB;
constexpr size_t WS_UX = 356 * MiB;
constexpr size_t WS_MG = 500 * MiB;
constexpr size_t WS_END = 700 * MiB;
static_assert(WS_MG + (size_t)T * MGS * 2 <= WS_END, "MG fits");
static_assert(WS_SSQ + 4 * (size_t)T * 4 <= CTL_ZERO_BYTES, "ssq inside memset region");
constexpr int CW_BAR = 4096;

constexpr int LDS_BYTES = 147456;
constexpr int MISC_OFF = LDS_BYTES - 256;
constexpr int NWAVES = 8;

#define LDS_WAIT() asm volatile("s_waitcnt lgkmcnt(0)" ::: "memory")
#define VM_WAIT() asm volatile("s_waitcnt vmcnt(0)" ::: "memory")

__device__ __forceinline__ unsigned cvt_pk_bf16(float lo, float hi) { unsigned r; asm volatile("v_cvt_pk_bf16_f32 %0, %1, %2" : "=v"(r) : "v"(lo), "v"(hi)); return r; }
__device__ __forceinline__ float bf_lo(unsigned w) { return __uint_as_float(w << 16); }
__device__ __forceinline__ float bf_hi(unsigned w) { return __uint_as_float(w & 0xffff0000u); }
__device__ __forceinline__ float fast_sigmoid(float x) { return __builtin_amdgcn_rcpf(1.0f + __builtin_amdgcn_exp2f(-1.4426950409f * x)); }
__device__ __forceinline__ float silu_f(float x) { return x * fast_sigmoid(x); }
__device__ __forceinline__ float gelu_tanh_f(float x) { const float u = 0.7978845608f * (x + 0.044715f * x * x * x); return x * fast_sigmoid(2.0f * u); }

__device__ __forceinline__ void acc_zero(f32x4 (&acc)[2][2][4][2]) {
#pragma unroll
    for (int a = 0; a < 2; ++a)
#pragma unroll
        for (int b = 0; b < 2; ++b)
#pragma unroll
            for (int m = 0; m < 4; ++m)
#pragma unroll
                for (int n = 0; n < 2; ++n) acc[a][b][m][n] = (f32x4){0.f, 0.f, 0.f, 0.f};
}
#define EPI_ZERO_INIT __device__ __forceinline__ void init(f32x4 (&acc)[2][2][4][2], const pg8::Unit&, int, int, int, int) const { acc_zero(acc); }
namespace pg8 {
constexpr int BM = 256, BK = 64, HALF = 128, HTB = HALF * BK * 2, STAGE_BYTES = 8 * HTB, NXCD = 8, WGM = 8;
__host__ __device__ __forceinline__ int lds_byte(int r, int c) { const int st = (r >> 4) * 2 + (c >> 5), rr = r & 15, cc = c & 31, ob = rr * 64 + cc * 2; return st * 1024 + (ob ^ (((ob >> 9) & 1) << 5)); }
__host__ __device__ __forceinline__ void stage_rc(int b, int& R, int& C) { const int st = b / 1024, sb = b % 1024, swz = sb ^ (((sb >> 9) & 1) << 5); R = (st >> 1) * 16 + swz / 64; C = (st & 1) * 32 + (swz % 64) / 2; }
__host__ __device__ __forceinline__ int perm32(int rho) { const int n = rho >> 4, i = rho & 15; return 8 * (i >> 2) + 4 * n + (i & 3); }

struct Unit { int b, pm, pn; };
struct Gemm { const char* A; const char* Bt; size_t a_batch, b_batch; unsigned a_rs, a_gs; int K; };

struct BOrder {
    int nM, nN, per, nwg, G, c;
    __device__ void init(int nbatch, int nM_, int nN_, int G_, int c_) { nM = nM_; nN = nN_; per = nM * nN; nwg = nbatch * per; G = G_; c = c_; }
    __device__ bool next(int i, Unit& u) const {
        const long L = (long)i * G + c; if (L >= nwg) return false;
        int w = (int)L; { const int q = nwg / NXCD, r = nwg % NXCD, xcd = w % NXCD, off = w / NXCD; w = (xcd < r ? xcd * (q + 1) : r * (q + 1) + (xcd - r) * q) + off; }
        const int b = w / per, rr = w - b * per;
        const int nig = WGM * nN, gid = rr / nig, fm = gid * WGM, gsz = (nM - fm) < WGM ? (nM - fm) : WGM;
        u.b = b; u.pm = fm + ((rr % nig) % gsz); u.pn = (rr % nig) / gsz; return true;
    }
};

template <class Epi, class Sched>
__device__ __forceinline__ void gemm_phase(LAS unsigned char* lds, const Gemm g, const Sched& S, const Epi& E) {
    int tid_ = threadIdx.x; asm volatile("" : "+v"(tid_));
    const int tid = tid_, wid = __builtin_amdgcn_readfirstlane(tid >> 6), lane = tid & 63, wr = wid >> 2, wc = wid & 3, fr = lane & 15, fq = lane >> 4;
    const int K = g.K, nt = K / BK;
    unsigned voffA[2], voffB[2];
#pragma unroll
    for (int i = 0; i < 2; ++i) { int R, C; stage_rc(tid * 16 + i * 8192, R, C); const int Rb = Epi::PERM ? ((R & ~31) + perm32(R & 31)) : R;
        voffA[i] = (unsigned)R * g.a_rs + (unsigned)(C >> 4) * g.a_gs + (unsigned)(C & 15) * 2u; voffB[i] = (unsigned)(Rb * K + C) * 2u; }
    const size_t kstepA = (size_t)4 * g.a_gs, hstepA = (size_t)HALF * g.a_rs, tstepA = 2 * hstepA;
    const size_t kstepB = (size_t)(BK * 2), hstepB = (size_t)HALF * K * 2, tstepB = 2 * hstepB;
    const unsigned ldsw = (unsigned)wid * 1024u;
    const int aoff = lds_byte(wr * 64 + fr, fq * 8), boff = lds_byte(wc * 32 + fr, fq * 8);
#define PG8_SA(b, h) (((b) * 2 + (h)) * HTB)
#define PG8_SB(b, h) ((4 + (b) * 2 + (h)) * HTB)
#define PG8_STAGE(bufoff, gbase, voff) do { _Pragma("unroll") for (int _i = 0; _i < 2; ++_i) \
        __builtin_amdgcn_global_load_lds((const unsigned*)((const char*)(gbase) + (voff)[_i]), (LAS unsigned*)(lds + (bufoff) + ldsw + _i * 8192), 16, 0, 0); } while (0)
#define PG8_LDA(dst, b, h) do { _Pragma("unroll") for (int m = 0; m < 4; ++m) _Pragma("unroll") for (int k = 0; k < 2; ++k) dst[m][k] = *(const LAS bf16x8*)(lds + PG8_SA(b, h) + aoff + m * 2048 + k * 1024); } while (0)
#define PG8_LDB(dst, b, h) do { _Pragma("unroll") for (int n = 0; n < 2; ++n) _Pragma("unroll") for (int k = 0; k < 2; ++k) dst[n][k] = *(const LAS bf16x8*)(lds + PG8_SB(b, h) + boff + n * 2048 + k * 1024); } while (0)
#define PG8_MMA(ai, bj, At, Bt) do { __builtin_amdgcn_s_setprio(1); _Pragma("unroll") for (int m = 0; m < 4; ++m) _Pragma("unroll") for (int n = 0; n < 2; ++n) _Pragma("unroll") for (int k = 0; k < 2; ++k) \
        acc[ai][bj][m][n] = __builtin_amdgcn_mfma_f32_16x16x32_bf16(Bt[n][k], At[m][k], acc[ai][bj][m][n], 0, 0, 0); __builtin_amdgcn_s_setprio(0); } while (0)
#define PG8_WAIT_V(n) asm volatile("s_waitcnt vmcnt(" #n ")" ::: "memory")
#define PG8_WAIT_L(n) asm volatile("s_waitcnt lgkmcnt(" #n ")" ::: "memory")
#define PG8_BAR __builtin_amdgcn_s_barrier()
#define PG8_SCHED __builtin_amdgcn_sched_barrier(0)
    Unit cur, nxt; int ui = 0;
    if (!S.next(0, cur)) return;
    f32x4 acc[2][2][4][2];
    E.init(acc, cur, wr, wc, fr, fq);
    bf16x8 At[4][2], B0[2][2], B1[2][2];
    const char* cA = g.A + (size_t)cur.b * g.a_batch + (size_t)cur.pm * tstepA; const char* cB = g.Bt + (size_t)cur.b * g.b_batch + (size_t)cur.pn * tstepB;
    PG8_STAGE(PG8_SB(0, 0), cB, voffB); PG8_STAGE(PG8_SB(0, 1), cB + hstepB, voffB); PG8_STAGE(PG8_SA(0, 0), cA, voffA); PG8_STAGE(PG8_SA(0, 1), cA + hstepA, voffA);
    if (wr == 1) PG8_BAR;
    PG8_WAIT_V(2); PG8_BAR;
    PG8_STAGE(PG8_SB(1, 0), cB + kstepB, voffB); PG8_STAGE(PG8_SA(1, 0), cA + kstepA, voffA); PG8_STAGE(PG8_SB(1, 1), cB + hstepB + kstepB, voffB);
    PG8_WAIT_V(6); PG8_BAR;
    for (;;) {
        const bool has_next = S.next(ui + 1, nxt);
        const char* nA = has_next ? g.A + (size_t)nxt.b * g.a_batch + (size_t)nxt.pm * tstepA : cA; const char* nB = has_next ? g.Bt + (size_t)nxt.b * g.b_batch + (size_t)nxt.pn * tstepB : cB;
        for (int t = 0; t < nt; t += 2) {
            const bool last = (t == nt - 2);
            const char* a1 = cA + (size_t)(t + 1) * kstepA;
            const char* a2 = last ? nA : cA + (size_t)(t + 2) * kstepA; const char* b2 = last ? nB : cB + (size_t)(t + 2) * kstepB;
            const char* a3 = a2 + kstepA; const char* b3 = b2 + kstepB;
            PG8_LDB(B0, 0, 0); PG8_LDB(B1, 0, 1); PG8_SCHED; PG8_LDA(At, 0, 0); PG8_STAGE(PG8_SA(1, 1), a1 + hstepA, voffA);
            PG8_WAIT_V(8); PG8_WAIT_L(0); PG8_BAR; PG8_MMA(0, 0, At, B0); PG8_MMA(0, 1, At, B1); PG8_BAR; PG8_SCHED;
            PG8_LDA(At, 0, 1); PG8_STAGE(PG8_SB(0, 0), b2, voffB); PG8_STAGE(PG8_SB(0, 1), b2 + hstepB, voffB); PG8_STAGE(PG8_SA(0, 0), a2, voffA);
            PG8_WAIT_V(8); PG8_WAIT_L(0); PG8_BAR; PG8_MMA(1, 0, At, B0); PG8_MMA(1, 1, At, B1); PG8_BAR; PG8_SCHED;
            PG8_LDB(B0, 1, 0); PG8_LDB(B1, 1, 1); PG8_SCHED; PG8_LDA(At, 1, 0); PG8_STAGE(PG8_SA(0, 1), a2 + hstepA, voffA);
            PG8_WAIT_V(8); PG8_WAIT_L(0); PG8_BAR; PG8_MMA(0, 0, At, B0); PG8_MMA(0, 1, At, B1); PG8_BAR; PG8_SCHED;
            PG8_LDA(At, 1, 1); PG8_STAGE(PG8_SB(1, 0), b3, voffB); PG8_STAGE(PG8_SB(1, 1), b3 + hstepB, voffB); PG8_STAGE(PG8_SA(1, 0), a3, voffA);
            PG8_WAIT_V(8); PG8_WAIT_L(0); PG8_BAR; PG8_MMA(1, 0, At, B0); PG8_MMA(1, 1, At, B1); PG8_BAR; PG8_SCHED;
        }
        if (wr == 0) PG8_BAR;
        E(acc, cur, wr, wc, fr, fq);
        if (!has_next) break;
        E.init(acc, nxt, wr, wc, fr, fq);
        cur = nxt; cA = nA; cB = nB; ++ui;
        if (wr == 1) PG8_BAR;
    }
    PG8_WAIT_V(0);
    PG8_BAR;
#undef PG8_SA
#undef PG8_SB
#undef PG8_STAGE
#undef PG8_LDA
#undef PG8_LDB
#undef PG8_MMA
#undef PG8_WAIT_V
#undef PG8_WAIT_L
#undef PG8_BAR
#undef PG8_SCHED
}
}

struct EpiA {
    static constexpr bool PERM = true;
    EPI_ZERO_INIT
    const float* ssq; bf16* VB; bf16* MG; bf16* UX;
    __device__ __forceinline__ void operator()(const f32x4 (&acc)[2][2][4][2], const pg8::Unit& u, int wr, int wc, int fr, int fq) const {
        const int row0 = u.pm * 256 + wr * 64 + fr;
        float inv[2][4];
#pragma unroll
        for (int ai = 0; ai < 2; ++ai)
#pragma unroll
            for (int m = 0; m < 4; ++m) inv[ai][m] = ssq[row0 + ai * 128 + m * 16];
#pragma unroll
        for (int ai = 0; ai < 2; ++ai)
#pragma unroll
            for (int m = 0; m < 4; ++m) inv[ai][m] = __builtin_amdgcn_rsqf(inv[ai][m] * (1.0f / DM) + EPS);
        const int seg = u.pn >> 2;
        const int cseg = (u.pn & 3) * 256 + wc * 32 + 8 * fq;
        if (seg == 2) {
#pragma unroll
            for (int ai = 0; ai < 2; ++ai)
#pragma unroll
                for (int m = 0; m < 4; ++m) { const int r = row0 + ai * 128 + m * 16; const float sc = inv[ai][m];
#pragma unroll
                    for (int bj = 0; bj < 2; ++bj) { const int c = cseg + bj * 128; const f32x4 v0 = acc[ai][bj][m][0] * sc, v1 = acc[ai][bj][m][1] * sc;
                        u32x4 w; w.x = cvt_pk_bf16(v0[0], v0[1]); w.y = cvt_pk_bf16(v0[2], v0[3]); w.z = cvt_pk_bf16(v1[0], v1[1]); w.w = cvt_pk_bf16(v1[2], v1[3]);
                        bf16* p = UX + ((size_t)(c >> 4) * NCH + (r >> 5)) * UXW + (r & 31) * 16 + (c & 15);
                        *(u32x4*)p = w; } }
        } else {
            bf16* base = (seg == 0) ? VB : (seg == 1 ? MG : MG + 1024); const int rs = (seg == 0) ? 1024 : MGS; const bool act = (seg != 0);
#pragma unroll
            for (int ai = 0; ai < 2; ++ai)
#pragma unroll
                for (int m = 0; m < 4; ++m) { const int r = row0 + ai * 128 + m * 16; const float sc = inv[ai][m];
#pragma unroll
                    for (int bj = 0; bj < 2; ++bj) { const int c = cseg + bj * 128; f32x4 v0 = acc[ai][bj][m][0] * sc, v1 = acc[ai][bj][m][1] * sc;
                        if (act) {
#pragma unroll
                            for (int e = 0; e < 4; ++e) { v0[e] = silu_f(v0[e]); v1[e] = silu_f(v1[e]); } }
                        u32x4 w; w.x = cvt_pk_bf16(v0[0], v0[1]); w.y = cvt_pk_bf16(v0[2], v0[3]); w.z = cvt_pk_bf16(v1[0], v1[1]); w.w = cvt_pk_bf16(v1[2], v1[3]);
                        *(u32x4*)(base + (size_t)r * rs + c) = w; } }
        }
    }
};
struct EpiS {
    static constexpr bool PERM = false;
    EPI_ZERO_INIT
    float* S;
    __device__ __forceinline__ void operator()(const f32x4 (&acc)[2][2][4][2], const pg8::Unit& u, int wr, int wc, int fr, int fq) const {
        const int row0 = u.pm * 256 + wr * 64 + fr, col0 = wc * 32 + 4 * fq;
#pragma unroll
        for (int ai = 0; ai < 2; ++ai)
#pragma unroll
            for (int m = 0; m < 4; ++m) { float* rowp = S + ((size_t)u.b * NCH + row0 + ai * 128 + m * 16) * 256 + col0;
#pragma unroll
                for (int bj = 0; bj < 2; ++bj)
#pragma unroll
                    for (int n = 0; n < 2; ++n) *(f32x4*)(rowp + bj * 128 + n * 16) = acc[ai][bj][m][n]; }
    }
};
struct EpiY {
    static constexpr bool PERM = true;
    EPI_ZERO_INIT
    bf16* YG;
    __device__ __forceinline__ void operator()(const f32x4 (&acc)[2][2][4][2], const pg8::Unit& u, int wr, int wc, int fr, int fq) const {
        const int row0 = u.pm * 256 + wr * 64 + fr, col0 = u.pn * 256 + wc * 32 + 8 * fq;
#pragma unroll
        for (int ai = 0; ai < 2; ++ai)
#pragma unroll
            for (int m = 0; m < 4; ++m) { bf16* rowp = YG + ((size_t)u.b * NCH + row0 + ai * 128 + m * 16) * 512 + col0;
#pragma unroll
                for (int bj = 0; bj < 2; ++bj) { f32x4 v0 = acc[ai][bj][m][0], v1 = acc[ai][bj][m][1];
#pragma unroll
                    for (int e = 0; e < 4; ++e) { v0[e] = gelu_tanh_f(v0[e]); v1[e] = gelu_tanh_f(v1[e]); }
                    u32x4 w; w.x = cvt_pk_bf16(v0[0], v0[1]); w.y = cvt_pk_bf16(v0[2], v0[3]); w.z = cvt_pk_bf16(v1[0], v1[1]); w.w = cvt_pk_bf16(v1[2], v1[3]);
                    *(u32x4*)(rowp + bj * 128) = w; } }
    }
};
struct EpiGlu {
    static constexpr bool PERM = false;
    EPI_ZERO_INIT
    bf16* MG; const float* b1; const float* b2;
    __device__ __forceinline__ void operator()(const f32x4 (&acc)[2][2][4][2], const pg8::Unit& u, int wr, int wc, int fr, int fq) const {
        const int row0 = u.pm * 256 + wr * 64 + fr, cb = u.pn * 128 + wc * 16 + 4 * fq;
        f32x4 B1[2], B2[2];
#pragma unroll
        for (int bj = 0; bj < 2; ++bj) { B1[bj] = *(const f32x4*)(b1 + cb + bj * 64); B2[bj] = *(const f32x4*)(b2 + cb + bj * 64); }
        u32x2 sgv[2][4][2];
#pragma unroll
        for (int ai = 0; ai < 2; ++ai)
#pragma unroll
            for (int m = 0; m < 4; ++m)
#pragma unroll
                for (int bj = 0; bj < 2; ++bj) sgv[ai][m][bj] = *(const u32x2*)(MG + (size_t)(row0 + ai * 128 + m * 16) * MGS + 1024 + cb + bj * 64);
#pragma unroll
        for (int ai = 0; ai < 2; ++ai)
#pragma unroll
            for (int m = 0; m < 4; ++m) { bf16* rowp = MG + (size_t)(row0 + ai * 128 + m * 16) * MGS + 1024 + cb;
#pragma unroll
                for (int bj = 0; bj < 2; ++bj) { const u32x2 sg = sgv[ai][m][bj];
                    const f32x4 a = acc[ai][bj][m][0] + B1[bj], b = acc[ai][bj][m][1] + B2[bj];
                    const float o0 = a[0] * fast_sigmoid(b[0]) * bf_lo(sg.x), o1 = a[1] * fast_sigmoid(b[1]) * bf_hi(sg.x);
                    const float o2 = a[2] * fast_sigmoid(b[2]) * bf_lo(sg.y), o3 = a[3] * fast_sigmoid(b[3]) * bf_hi(sg.y);
                    u32x2 w; w.x = cvt_pk_bf16(o0, o1); w.y = cvt_pk_bf16(o2, o3);
                    *(u32x2*)(rowp + bj * 64) = w; } }
    }
};
struct EpiOut {
    static constexpr bool PERM = false;
    const float* base_p; const float* base_s; float* out; bf16* xb; float* ssq;
    __device__ __forceinline__ void init(f32x4 (&acc)[2][2][4][2], const pg8::Unit& u, int wr, int wc, int fr, int fq) const {
        const int row0 = u.pm * 256 + wr * 64 + fr, col0 = u.pn * 256 + wc * 32 + 4 * fq;
        const float* bb = (u.pm < TP / 256) ? base_p : base_s - (size_t)TP * DM;
#pragma unroll
        for (int ai = 0; ai < 2; ++ai)
#pragma unroll
            for (int m = 0; m < 4; ++m) { const size_t off = (size_t)(row0 + ai * 128 + m * 16) * DM + col0;
#pragma unroll
                for (int bj = 0; bj < 2; ++bj)
#pragma unroll
                    for (int n = 0; n < 2; ++n) acc[ai][bj][m][n] = *(const f32x4*)(bb + off + bj * 128 + n * 16); }
    }
    __device__ __forceinline__ void operator()(const f32x4 (&acc)[2][2][4][2], const pg8::Unit& u, int wr, int wc, int fr, int fq) const {
        const int row0 = u.pm * 256 + wr * 64 + fr, col0 = u.pn * 256 + wc * 32 + 4 * fq;
#pragma unroll
        for (int ai = 0; ai < 2; ++ai)
#pragma unroll
            for (int m = 0; m < 4; ++m) { const int r = row0 + ai * 128 + m * 16; const size_t off = (size_t)r * DM + col0; float s = 0.f;
#pragma unroll
                for (int bj = 0; bj < 2; ++bj)
#pragma unroll
                    for (int n = 0; n < 2; ++n) { const f32x4 o = acc[ai][bj][m][n];
                        *(f32x4*)(out + off + bj * 128 + n * 16) = o; s += (o[0] * o[0] + o[1] * o[1]) + (o[2] * o[2] + o[3] * o[3]);
                        if (xb) { u32x2 w; w.x = cvt_pk_bf16(o[0], o[1]); w.y = cvt_pk_bf16(o[2], o[3]); *(u32x2*)(xb + off + bj * 128 + n * 16) = w; } }
                s += __shfl_xor(s, 16); s += __shfl_xor(s, 32);
                if (fq == 0) atomicAdd(ssq + r, s); }
    }
};
struct EpiNull {
    static constexpr bool PERM = false;
    EPI_ZERO_INIT
    __device__ __forceinline__ void operator()(const f32x4 (&acc)[2][2][4][2], const pg8::Unit& u, int wr, int wc, int fr, int fq) const {
#pragma unroll
        for (int ai = 0; ai < 2; ++ai)
#pragma unroll
            for (int bj = 0; bj < 2; ++bj)
#pragma unroll
                for (int m = 0; m < 4; ++m)
#pragma unroll
                    for (int n = 0; n < 2; ++n) asm volatile("" :: "v"(acc[ai][bj][m][n]));
    }
};
#define XB_TMO      128
#define XB_XCNT(j)  (256  + 64 * (j))
#define XB_XSUB(j)  (1280 + 64 * (j))
#define XB_XGEN(j)  (2304 + 64 * (j))
#define XB_TOP      3328
#define XB_TOPGEN   3392
#define XCD_BAR_WORDS 3456
#define XB_SPIN_CAP (1u << 18)
__device__ __forceinline__ unsigned xb_ld(unsigned* p)              { return __hip_atomic_load(p, __ATOMIC_RELAXED, __HIP_MEMORY_SCOPE_AGENT); }
__device__ __forceinline__ unsigned xb_add(unsigned* p, unsigned v) { return __hip_atomic_fetch_add(p, v, __ATOMIC_RELAXED, __HIP_MEMORY_SCOPE_AGENT); }
__device__ __forceinline__ unsigned xb_xcc_id() { return (unsigned)__builtin_amdgcn_s_getreg((3 << 11) | 20) & 0xFu; }
#define XB_SPIN(cond, bar) do { unsigned _sp = 0; while (cond) { __builtin_amdgcn_s_sleep(1); \
    if ((++_sp & 255u) == 0u) { if (xb_ld(&(bar)[XB_TMO])) break; if (_sp > XB_SPIN_CAP) { atomicAdd(&(bar)[XB_TMO], 1u); break; } } } } while (0)
struct XcdBarrier { unsigned* bar; unsigned x; volatile LAS unsigned* st; };
__device__ __forceinline__ XcdBarrier xcd_barrier_post(unsigned* bar, volatile LAS unsigned* st) {
    XcdBarrier b; b.bar = bar; b.x = xb_xcc_id(); b.st = st;
    if (threadIdx.x == 0) (void)xb_add(&bar[XB_XCNT(b.x)], 1u);
    return b;
}
__device__ __forceinline__ void xcd_barrier_complete(unsigned* bar, unsigned x, unsigned& nloc, unsigned& nx) {
    const unsigned G = gridDim.x * gridDim.y * gridDim.z;
    unsigned sum, cnt, mine, sp = 0u;
    for (;;) {
        sum = 0u; cnt = 0u; mine = 0u;
#pragma unroll
        for (unsigned j = 0; j < 16; ++j) { const unsigned c = xb_ld(&bar[XB_XCNT(j)]); sum += c; cnt += (c > 0u) ? 1u : 0u; mine = (j == x) ? c : mine; }
        if (sum == G) break;
        __builtin_amdgcn_s_sleep(1);
        if ((++sp & 255u) == 0u) { if (xb_ld(&bar[XB_TMO])) break; if (sp > XB_SPIN_CAP) { atomicAdd(&bar[XB_TMO], 1u); break; } }
    }
    nloc = mine > 0u ? mine : 1u; nx = cnt > 0u ? cnt : 1u;
}
__device__ __forceinline__ void xcd_barrier(const XcdBarrier& b) {
    asm volatile("s_waitcnt vmcnt(0)" ::: "memory");
    __syncthreads();
    if (threadIdx.x == 0) {
        unsigned* bar = b.bar; asm volatile("" : "+s"(bar));
        __builtin_amdgcn_s_waitcnt(0);
        unsigned nloc = b.st[0], nx = b.st[1];
        if (nloc == 0u) { xcd_barrier_complete(bar, b.x, nloc, nx); b.st[0] = nloc; b.st[1] = nx; }
        const unsigned old = xb_add(&bar[XB_XSUB(b.x)], 1u);
        const unsigned gen = old / nloc;
        if (old + 1u == (gen + 1u) * nloc) {
            __builtin_amdgcn_fence(__ATOMIC_RELEASE, "agent");
            asm volatile("s_waitcnt vmcnt(0)" ::: "memory");
            const unsigned og = xb_add(&bar[XB_TOP], 1u);
            const unsigned tg = og / nx;
            if (og + 1u == (tg + 1u) * nx) xb_add(&bar[XB_TOPGEN], 1u);
            else XB_SPIN(xb_ld(&bar[XB_TOPGEN]) == tg, bar);
            __builtin_amdgcn_fence(__ATOMIC_ACQUIRE, "agent");
            xb_add(&bar[XB_XGEN(b.x)], 1u);
            asm volatile("s_waitcnt vmcnt(0)" ::: "memory");
        } else {
            XB_SPIN(xb_ld(&bar[XB_XGEN(b.x)]) == gen, bar);
            __builtin_amdgcn_fence(__ATOMIC_ACQUIRE, "agent");
            asm volatile("s_waitcnt vmcnt(0)" ::: "memory");
        }
    }
    __syncthreads();
}

struct Args {
    const float* xp; const float* xs; const float* norm_g; const float* w_in; const float* pool_w; const float* pool_scale;
    const float* lam_re; const float* lam_im; const float* log_step; const float* b_re; const float* b_im; const float* c_re; const float* c_im;
    const float* d_skip; const float* glu_w1; const float* glu_b1; const float* glu_w2; const float* glu_b2; const float* w_out; const float* final_g;
    float* out; unsigned char* ws;
};

__device__ __forceinline__ f32x2 cmul(f32x2 a, f32x2 b) { return (f32x2){a.x * b.x - a.y * b.y, a.x * b.y + a.y * b.x}; }
__device__ __forceinline__ f32x2 cexp_pow(float lr, float li, float st, float n) {
    const float mag = __builtin_amdgcn_exp2f(lr * st * n * 1.4426950409f);
    const double q4 = (double)li * (double)st * (double)n * 0.63661977236758134308;
    const double kq = __builtin_rint(q4);
    const float y = (float)((q4 - kq) * 1.57079632679489661923);
    const int q = (int)((long long)kq & 3ll);
    const float y2 = y * y;
    const float sn = y + y * y2 * (-1.6666667163e-1f + y2 * (8.3333337680e-3f + y2 * (-1.9841270114e-4f + y2 * 2.7557314297e-6f)));
    const float cs = 1.0f + y2 * (-0.5f + y2 * (4.1666667908e-2f + y2 * (-1.3888889225e-3f + y2 * (2.4801587642e-5f + y2 * -2.7557314297e-7f))));
    float c, s;
    if (q == 0) { c = cs; s = sn; } else if (q == 1) { c = -sn; s = cs; } else if (q == 2) { c = -cs; s = -sn; } else { c = sn; s = -cs; }
    return (f32x2){mag * c, mag * s};
}

template <class RowMap>
__device__ __forceinline__ void transpose_item(const float* W, int ldn, int K, int k0, int n0, bf16* WT, RowMap rm, const float* kscale, LAS float* scr, int lane) {
    f32x4 v[16];
    const int kq = lane >> 4, n4 = (lane & 15) * 4;
#pragma unroll
    for (int i = 0; i < 16; ++i) v[i] = *(const f32x4*)(W + (size_t)(k0 + 4 * i + kq) * ldn + n0 + n4);
#pragma unroll
    for (int i = 0; i < 16; ++i) { const int kk = 4 * i + kq; const float sc = kscale ? kscale[k0 + kk] : 1.0f; LAS float* d = scr + kk * 65 + n4;
        d[0] = v[i][0] * sc; d[1] = v[i][1] * sc; d[2] = v[i][2] * sc; d[3] = v[i][3] * sc; }
    LDS_WAIT(); asm volatile("" ::: "memory");
    const int c = lane & 7;
#pragma unroll
    for (int j = 0; j < 8; ++j) { const int n = (lane >> 3) + 8 * j; const LAS float* s = scr + (8 * c) * 65 + n;
        u32x4 o; o.x = cvt_pk_bf16(s[0 * 65], s[1 * 65]); o.y = cvt_pk_bf16(s[2 * 65], s[3 * 65]); o.z = cvt_pk_bf16(s[4 * 65], s[5 * 65]); o.w = cvt_pk_bf16(s[6 * 65], s[7 * 65]);
        *(u32x4*)(WT + (size_t)rm(n0 + n) * K + k0 + 8 * c) = o; }
    LDS_WAIT(); asm volatile("" ::: "memory");
}
struct RowId { int off; __device__ __forceinline__ int operator()(int n) const { return n + off; } };
struct RowGlu { int which; __device__ __forceinline__ int operator()(int n) const { return 32 * (n >> 4) + 16 * which + (n & 15); } };

__device__ __forceinline__ void p0_ssm_item(const Args& a, LAS unsigned char* lds, int l, int g, int half, int tid) {
    LAS f32x2* AP = (LAS f32x2*)lds;
    LAS f32x2* BB = (LAS f32x2*)(lds + 33792);
    LAS f32x2* CC = (LAS f32x2*)(lds + 50176);
    LAS float* KK = (LAS float*)(lds + 66560);
    for (int idx = tid; idx < 2 * 64 * 33; idx += 512) { const int d = idx / (64 * 33), rem = idx - d * 64 * 33, p = rem / 33, tau = rem - p * 33;
        const int li = ((l * 2 + d) * 64 + g) * 64 + p; const float st = expf(a.log_step[(l * 2 + d) * 64 + g]);
        AP[idx] = cexp_pow(a.lam_re[li], a.lam_im[li], st, (float)tau); }
    for (int idx = tid; idx < 2 * 64 * 16; idx += 512) { const int d = idx >> 10, p = (idx >> 4) & 63, h = idx & 15;
        const int li = ((l * 2 + d) * 64 + g) * 64 + p; const float lr = a.lam_re[li], lim = a.lam_im[li], st = expf(a.log_step[(l * 2 + d) * 64 + g]);
        const f32x2 a1 = cexp_pow(lr, lim, st, 1.0f); const float nr = a1.x - 1.0f, ni = a1.y, den = 1.0f / (lr * lr + lim * lim);
        const f32x2 coef = (f32x2){(nr * lr + ni * lim) * den, (ni * lr - nr * lim) * den};
        const size_t bi = ((size_t)li) * 16 + h;
        BB[idx] = cmul(coef, (f32x2){a.b_re[bi], a.b_im[bi]});
        const size_t ci = ((size_t)((l * 2 + d) * 64 + g) * 16 + h) * 64 + p;
        CC[idx] = (f32x2){a.c_re[ci], a.c_im[ci]}; }
    __syncthreads();
#pragma unroll 1
    for (int j = 0; j < 2; ++j) { const int q = tid + 512 * j, h = q & 15, tau = (q >> 4) & 31, d = q >> 9;
        float ac[16];
#pragma unroll
        for (int e = 0; e < 16; ++e) ac[e] = 0.f;
        for (int p = 0; p < 64; ++p) { const f32x2 m = cmul(CC[(d * 64 + p) * 16 + h], AP[(d * 64 + p) * 33 + tau]);
#pragma unroll
            for (int e = 0; e < 16; ++e) { const f32x2 b = BB[(d * 64 + p) * 16 + e]; ac[e] += m.x * b.x - m.y * b.y; } }
#pragma unroll
        for (int e = 0; e < 16; ++e) KK[((d * 32 + tau) * 16 + h) * 16 + e] = ac[e]; }
    __syncthreads();
    { const int d = half; bf16* W1 = (bf16*)(a.ws + WS_W1OP) + ((size_t)(l * NG + g) * 256 + d * 128) * 512;
      for (int idx = tid; idx < 128 * 64; idx += 512) { const int rr = idx >> 6, j = idx & 63, p = rr >> 1, ri = rr & 1, s = j >> 1, h0 = (j & 1) * 8;
          const f32x2 pw = AP[(d * 64 + p) * 33 + (d == 0 ? (QC - 1 - s) : s)]; float v[8];
#pragma unroll
          for (int e = 0; e < 8; ++e) { const f32x2 m = cmul(pw, BB[(d * 64 + p) * 16 + h0 + e]); v[e] = ri ? m.y : m.x; }
          u32x4 o; o.x = cvt_pk_bf16(v[0], v[1]); o.y = cvt_pk_bf16(v[2], v[3]); o.z = cvt_pk_bf16(v[4], v[5]); o.w = cvt_pk_bf16(v[6], v[7]);
          *(u32x4*)(W1 + (size_t)rr * 512 + j * 8) = o; } }
    { bf16* TW = (bf16*)(a.ws + WS_TW) + (size_t)(l * NG + g) * 512 * UXW;
      for (int idx = tid; idx < 256 * 96; idx += 512) { const int rr = idx / 96, j = idx - rr * 96, t = 16 * half + (rr >> 4), h = rr & 15; float v[8];
          if (j < 64) { const int s = j >> 1, h0 = (j & 1) * 8;
              if (t > s) {
#pragma unroll
                  for (int e = 0; e < 8; ++e) v[e] = KK[((0 * 32 + (t - s)) * 16 + h) * 16 + h0 + e];
              } else if (t < s) {
#pragma unroll
                  for (int e = 0; e < 8; ++e) v[e] = KK[((1 * 32 + (s - t)) * 16 + h) * 16 + h0 + e];
              } else { const float dsk = a.d_skip[l * 1024 + g * 16 + h];
#pragma unroll
                  for (int e = 0; e < 8; ++e) v[e] = KK[((0 * 32) * 16 + h) * 16 + h0 + e] + KK[((1 * 32) * 16 + h) * 16 + h0 + e] + ((h0 + e == h) ? dsk : 0.f); }
          } else { const int xi = (j - 64) * 8, d = xi >> 7, p0 = (xi & 127) >> 1; const int ex = (d == 0) ? (t + 1) : (QC - t);
#pragma unroll
              for (int e = 0; e < 4; ++e) { const f32x2 m = cmul(CC[(d * 64 + p0 + e) * 16 + h], AP[(d * 64 + p0 + e) * 33 + ex]); v[2 * e] = m.x; v[2 * e + 1] = -m.y; } }
          u32x4 o; o.x = cvt_pk_bf16(v[0], v[1]); o.y = cvt_pk_bf16(v[2], v[3]); o.z = cvt_pk_bf16(v[4], v[5]); o.w = cvt_pk_bf16(v[6], v[7]);
          *(u32x4*)(TW + (size_t)(t * 16 + h) * UXW + j * 8) = o; } }
    __syncthreads();
}
__device__ __forceinline__ void p0_fold_item(const Args& a, LAS unsigned char* lds, int l, int gq, int kb, int tid) {
    LAS float* Wl = (LAS float*)lds;
    constexpr int LD = 260;
    for (int idx = tid; idx < 32 * 64; idx += 512) { const int kk = idx >> 6, c4 = (idx & 63) * 4;
        const f32x4 w = *(const f32x4*)(a.w_in + ((size_t)(l * 1024 + kb * 32 + kk)) * NCOL + gq * 256 + c4);
        *(LAS f32x4*)(Wl + kk * LD + c4) = w; }
    __syncthreads();
    const int d0 = (tid & 63) * 4, kg = tid >> 6;
    f32x4 ac[4];
#pragma unroll
    for (int e = 0; e < 4; ++e) ac[e] = (f32x4){0.f, 0.f, 0.f, 0.f};
    const float* pw = a.pool_w + ((size_t)(l * 4 + gq) * 256) * 256 + d0;
#pragma unroll 1
    for (int c = 0; c < 256; c += 16) { f32x4 p[16];
#pragma unroll
        for (int q = 0; q < 16; ++q) p[q] = *(const f32x4*)(pw + (size_t)(c + q) * 256);
#pragma unroll
        for (int q4 = 0; q4 < 4; ++q4)
#pragma unroll
            for (int e = 0; e < 4; ++e) { const f32x4 w = *(const LAS f32x4*)(Wl + (kg * 4 + e) * LD + c + 4 * q4); ac[e] += w[0] * p[4 * q4] + w[1] * p[4 * q4 + 1] + w[2] * p[4 * q4 + 2] + w[3] * p[4 * q4 + 3]; } }
    const f32x4 sc = *(const f32x4*)(a.pool_scale + l * 1024 + gq * 256 + d0);
    const float* ng = a.norm_g + l * 1024 + kb * 32 + kg * 4;
    const float g0 = ng[0], g1 = ng[1], g2 = ng[2], g3 = ng[3];
#pragma unroll
    for (int dd = 0; dd < 4; ++dd) { bf16* o = (bf16*)(a.ws + WS_BT1) + ((size_t)l * NCOL + gq * 256 + d0 + dd) * DM + kb * 32 + kg * 4;
        u32x2 w; w.x = cvt_pk_bf16(ac[0][dd] * sc[dd] * g0, ac[1][dd] * sc[dd] * g1); w.y = cvt_pk_bf16(ac[2][dd] * sc[dd] * g2, ac[3][dd] * sc[dd] * g3); *(u32x2*)o = w; }
    __syncthreads();
}
__device__ __forceinline__ float wave_sum(float v) {
#pragma unroll
    for (int o = 1; o < 64; o <<= 1) v += __shfl_xor(v, o);
    return v;
}

__device__ __forceinline__ void scan_item(const Args& a, LAS unsigned char* lds, int l, int g, int d, int oct, int wave, int lane) {
    const float* S = (const float*)(a.ws + WS_R1) + (size_t)g * NCH * 256 + d * 128 + 2 * lane;
    bf16* UX = (bf16*)(a.ws + WS_UX) + (size_t)g * NCH * UXW + 512 + d * 128 + 2 * lane;
    const int li = ((l * 2 + d) * 64 + g) * 64 + lane; const float lr = a.lam_re[li], lim = a.lam_im[li], st = expf(a.log_step[(l * 2 + d) * 64 + g]);
    const f32x2 aQ = cexp_pow(lr, lim, st, (float)QC);
    const int c0 = (oct < 2) ? (oct * 8 + wave) * 64 : 1024 + wave * 64;
    f32x2 X = (f32x2){0.f, 0.f};
    if (oct == 2) {
        f32x2 F = (f32x2){0.f, 0.f};
#pragma unroll 1
        for (int cb = 0; cb < 4; ++cb) { f32x2 sv[16];
#pragma unroll
            for (int i = 0; i < 16; ++i) { const int k = cb * 16 + i; const int c = (d == 0) ? (c0 + k) : (c0 + 63 - k); sv[i] = *(const f32x2*)(S + (size_t)c * 256); }
#pragma unroll
            for (int i = 0; i < 16; ++i) { F = cmul(aQ, F) + sv[i]; } }
        LAS f32x2* FL = (LAS f32x2*)lds;
        FL[wave * 64 + lane] = F;
        __syncthreads();
        const f32x2 A64 = cexp_pow(lr, lim, st, (float)(QC * 64));
        if (d == 0) { for (int w = 0; w < wave; ++w) X = cmul(A64, X) + FL[w * 64 + lane]; }
        else { for (int w = 7; w > wave; --w) X = cmul(A64, X) + FL[w * 64 + lane]; }
        __syncthreads();
    }
#pragma unroll 1
    for (int cb = 0; cb < 4; ++cb) { f32x2 sv[16];
#pragma unroll
        for (int i = 0; i < 16; ++i) { const int k = cb * 16 + i; const int c = (d == 0) ? (c0 + k) : (c0 + 63 - k); sv[i] = *(const f32x2*)(S + (size_t)c * 256); }
#pragma unroll
        for (int i = 0; i < 16; ++i) { const int k = cb * 16 + i; const int c = (d == 0) ? (c0 + k) : (c0 + 63 - k);
            *(unsigned*)(UX + (size_t)c * UXW) = cvt_pk_bf16(X.x, X.y);
            X = cmul(aQ, X) + sv[i]; } }
}
__device__ __forceinline__ void pool_item(const Args& a, int rb, int gq, int lane) {
    const bf16* __restrict__ VB = (const bf16*)(a.ws + WS_R2) + gq * 256 + 4 * lane;
    bf16* __restrict__ MG = (bf16*)(a.ws + WS_MG) + gq * 256 + 4 * lane;
    const int half = 1 << gq;
    const int t0 = rb * 128;
    const int ss = (t0 < TP) ? (t0 & ~2047) : TP, se = (t0 < TP) ? ss + 2048 : T;
    float w0 = 0.f, w1 = 0.f, w2 = 0.f, w3 = 0.f;
    { const int lo = max(t0 - half, ss), hi = min(t0 + half, se);
      for (int j = lo; j < hi; ++j) { const u32x2 v = *(const u32x2*)(VB + (size_t)j * 1024); w0 += bf_lo(v.x); w1 += bf_hi(v.x); w2 += bf_lo(v.y); w3 += bf_hi(v.y); } }
#pragma unroll 1
    for (int tb = t0; tb < t0 + 128; tb += 8) {
        u32x2 vc[8], sg[8], vn[8], vo[8];
#pragma unroll
        for (int i = 0; i < 8; ++i) { const int t = tb + i;
            vc[i] = *(const u32x2*)(VB + (size_t)t * 1024);
            sg[i] = *(const u32x2*)(MG + (size_t)t * MGS);
            vn[i] = *(const u32x2*)(VB + (size_t)min(t + half, se - 1) * 1024);
            vo[i] = *(const u32x2*)(VB + (size_t)max(t - half, ss) * 1024); }
#pragma unroll
        for (int i = 0; i < 8; ++i) { const int t = tb + i;
            const int lo = max(t - half, ss), hi = min(t + half, se);
            const float rc = __builtin_amdgcn_rcpf((float)(hi - lo));
            const float o0 = (w0 * rc - bf_lo(vc[i].x)) * bf_lo(sg[i].x), o1 = (w1 * rc - bf_hi(vc[i].x)) * bf_hi(sg[i].x);
            const float o2 = (w2 * rc - bf_lo(vc[i].y)) * bf_lo(sg[i].y), o3 = (w3 * rc - bf_hi(vc[i].y)) * bf_hi(sg[i].y);
            u32x2 w; w.x = cvt_pk_bf16(o0, o1); w.y = cvt_pk_bf16(o2, o3);
            *(u32x2*)(MG + (size_t)t * MGS) = w;
            const float fn = (t + 1 + half <= se) ? 1.f : 0.f, fo = (t + 1 - half > ss) ? 1.f : 0.f;
            w0 += fn * bf_lo(vn[i].x) - fo * bf_lo(vo[i].x); w1 += fn * bf_hi(vn[i].x) - fo * bf_hi(vo[i].x);
            w2 += fn * bf_lo(vn[i].y) - fo * bf_lo(vo[i].y); w3 += fn * bf_hi(vn[i].y) - fo * bf_hi(vo[i].y); }
    }
}

__global__ void __launch_bounds__(NWAVES * 64, 2) mk_fwd(Args args) {
    extern __shared__ __attribute__((aligned(16))) unsigned char lds_raw[];
    LAS unsigned char* lds = (LAS unsigned char*)lds_raw;
    const int tid = threadIdx.x, lane = tid & 63, wave = __builtin_amdgcn_readfirstlane(tid >> 6);
    const int G = gridDim.x, bx = blockIdx.x;
    const int vcu = (G % 8 == 0) ? (bx % 8) * (G / 8) + bx / 8 : bx;
    const int gw = vcu * NWAVES + wave, NGW = G * NWAVES;
    unsigned char* ws = args.ws;
    unsigned* ctl = (unsigned*)(ws + WS_CTL);
    volatile LAS unsigned* MISC = (volatile LAS unsigned*)(lds + MISC_OFF);
    if (tid < 64) MISC[tid] = 0u;
    __syncthreads();
    XcdBarrier bar = xcd_barrier_post(ctl + CW_BAR, MISC);
    cg::grid_group grid = cg::this_grid();

    float* ssq = (float*)(ws + WS_SSQ);
    bf16* BT1 = (bf16*)(ws + WS_BT1); bf16* BTG = (bf16*)(ws + WS_BTG); bf16* BTO = (bf16*)(ws + WS_BTO);
    bf16* XB = (bf16*)(ws + WS_R1); bf16* VB = (bf16*)(ws + WS_R2); bf16* UX = (bf16*)(ws + WS_UX); bf16* MG = (bf16*)(ws + WS_MG);

#define PH_P0() do { \
        for (int it = bx; it < 256; it += G) p0_ssm_item(args, lds, it >> 7, (it >> 1) & 63, it & 1, tid); PSTAMP(); \
        for (int it = bx; it < 256; it += G) p0_fold_item(args, lds, it >> 7, (it >> 5) & 3, it & 31, tid); PSTAMP(); \
        LAS float* scr = (LAS float*)(lds + wave * 16640); \
        constexpr int I_IN = 16 * 48, I_GLU = 16 * 16, I_OUT = 32 * 16, PER_L = I_IN + 2 * I_GLU + I_OUT; \
        for (int it = gw; it < 2 * PER_L; it += NGW) { const int l = it / PER_L; int r = it - l * PER_L; \
            if (r < I_IN) { const int kb = r / 48, nb = r - kb * 48; \
                transpose_item(args.w_in + (size_t)l * DM * NCOL, NCOL, DM, kb * 64, 1024 + nb * 64, BT1 + (size_t)l * NCOL * DM, RowId{0}, args.norm_g + l * DM, scr, lane); continue; } \
            r -= I_IN; \
            if (r < I_GLU) { const int kb = r >> 4, nb = r & 15; \
                transpose_item(args.glu_w1 + (size_t)l * DM * DM, DM, DM, kb * 64, nb * 64, BTG + (size_t)l * 2048 * DM, RowGlu{0}, (const float*)nullptr, scr, lane); continue; } \
            r -= I_GLU; \
            if (r < I_GLU) { const int kb = r >> 4, nb = r & 15; \
                transpose_item(args.glu_w2 + (size_t)l * DM * DM, DM, DM, kb * 64, nb * 64, BTG + (size_t)l * 2048 * DM, RowGlu{1}, (const float*)nullptr, scr, lane); continue; } \
            r -= I_GLU; \
            { const int kb = r >> 4, nb = r & 15; \
                transpose_item(args.w_out + (size_t)l * 2048 * DM, DM, 2048, kb * 64, nb * 64, BTO + (size_t)l * DM * 2048, RowId{0}, (const float*)nullptr, scr, lane); } \
        } PSTAMP(); \
        for (int m = 4 * gw; m < T; m += 4 * NGW) { const float* xr = (m < TP) ? args.xp + (size_t)m * DM : args.xs + (size_t)(m - TP) * DM; \
            const f32x4* x4 = (const f32x4*)xr + lane; f32x4 v[16]; float sq[4]; \
            _Pragma("unroll") for (int j = 0; j < 16; ++j) v[j] = x4[64 * j]; \
            _Pragma("unroll") for (int rr = 0; rr < 4; ++rr) { float s0 = 0.f; \
                _Pragma("unroll") for (int j = 0; j < 4; ++j) { const f32x4 q = v[4 * rr + j]; s0 += (q[0] * q[0] + q[1] * q[1]) + (q[2] * q[2] + q[3] * q[3]); } \
                sq[rr] = wave_sum(s0); } \
            u32x2* o = (u32x2*)(XB + (size_t)m * DM) + lane; \
            _Pragma("unroll") for (int j = 0; j < 16; ++j) { u32x2 w; w.x = cvt_pk_bf16(v[j][0], v[j][1]); w.y = cvt_pk_bf16(v[j][2], v[j][3]); o[64 * j] = w; } \
            if (lane == 0) { ssq[m] = sq[0]; ssq[m + 1] = sq[1]; ssq[m + 2] = sq[2]; ssq[m + 3] = sq[3]; } } PSTAMP(); \
    } while (0)
#define PH_A(l) do { pg8::Gemm g{(const char*)XB, (const char*)(BT1 + (size_t)(l) * NCOL * DM), 0, 0, DM * 2, 32, DM}; \
          pg8::BOrder S; S.init(1, T / 256, NCOL / 256, G, bx); \
          EpiA E{ssq + (size_t)(l) * T, VB, MG, UX}; \
          pg8::gemm_phase<EpiA, pg8::BOrder>(lds, g, S, E); } while (0)
#define PH_B1(l) do { pg8::Gemm g{(const char*)UX, (const char*)((bf16*)(ws + WS_W1OP) + (size_t)(l) * NG * 256 * 512), (size_t)NCH * UXW * 2, (size_t)256 * 512 * 2, UXW * 2, 32, 512}; \
          pg8::BOrder S; S.init(NG, NCH / 256, 1, G, bx); \
          EpiS E{(float*)(ws + WS_R1)}; \
          pg8::gemm_phase<EpiS, pg8::BOrder>(lds, g, S, E); } while (0)
#define PH_IDS() int t2 = threadIdx.x; asm volatile("" : "+v"(t2)); const int lane2 = t2 & 63, wave2 = __builtin_amdgcn_readfirstlane(t2 >> 6), gw2 = vcu * NWAVES + wave2; (void)lane2; (void)gw2
#define PH_SCAN(l) do { PH_IDS(); for (int it = bx; it < 384; it += G) { scan_item(args, lds, (l), it & 63, (it >> 6) & 1, it >> 7, wave2, lane2); } } while (0)
#define PH_POOL() do { PH_IDS(); for (int it = NGW - 1 - gw2; it < 1536; it += NGW) pool_item(args, it >> 2, it & 3, lane2); } while (0)
#define PH_C(l) do { pg8::Gemm g{(const char*)UX, (const char*)((bf16*)(ws + WS_TW) + (size_t)(l) * NG * 512 * UXW), (size_t)NCH * UXW * 2, (size_t)512 * UXW * 2, UXW * 2, 32, UXW}; \
          pg8::BOrder S; S.init(NG, NCH / 256, 2, G, bx); \
          EpiY E{(bf16*)(ws + WS_R2)}; \
          pg8::gemm_phase<EpiY, pg8::BOrder>(lds, g, S, E); } while (0)
#define PH_D(l) do { pg8::Gemm g{(const char*)(ws + WS_R2), (const char*)(BTG + (size_t)(l) * 2048 * DM), 0, 0, 32, (unsigned)T * 32u, DM}; \
          pg8::BOrder S; S.init(1, T / 256, 2048 / 256, G, bx); \
          EpiGlu E{MG, args.glu_b1 + (l) * DM, args.glu_b2 + (l) * DM}; \
          pg8::gemm_phase<EpiGlu, pg8::BOrder>(lds, g, S, E); } while (0)
#define PH_E(l, bp, bs, op, xbp, sq) do { pg8::Gemm g{(const char*)MG, (const char*)(BTO + (size_t)(l) * DM * 2048), 0, 0, MGS * 2, 32, 2048}; \
          pg8::BOrder S; S.init(1, T / 256, DM / 256, G, bx); \
          EpiOut E{(bp), (bs), (op), (xbp), (sq)}; \
          pg8::gemm_phase<EpiOut, pg8::BOrder>(lds, g, S, E); } while (0)
#define PH_F(src, dst) do { PH_IDS(); \
        for (int m = 2 * gw2; m < T; m += 2 * NGW) { const f32x4* x4 = (const f32x4*)((src) + (size_t)m * DM) + lane2; f32x4* o4 = (f32x4*)((dst) + (size_t)m * DM) + lane2; const f32x4* g4 = (const f32x4*)args.final_g + lane2; \
            const float inv0 = __builtin_amdgcn_rsqf(ssq[2 * (size_t)T + m] * (1.0f / DM) + EPS), inv1 = __builtin_amdgcn_rsqf(ssq[2 * (size_t)T + m + 1] * (1.0f / DM) + EPS); \
            f32x4 v[8]; \
            _Pragma("unroll") for (int j = 0; j < 8; ++j) v[j] = x4[64 * j]; \
            _Pragma("unroll") for (int j = 0; j < 8; ++j) { const f32x4 gg = g4[64 * (j & 3)]; o4[64 * j] = v[j] * (j < 4 ? inv0 : inv1) * gg; } } } while (0)

#ifndef TS1
#define TS1 -1
#endif
#ifndef TS2
#define TS2 -1
#endif
#ifdef TSP
#define PSTAMP() STAMP()
#else
#define PSTAMP() do { } while (0)
#endif
#if TS1 >= 0
    int n_stamp = 0;
#define STAMP() do { if (bx == 0 && tid == 0) MISC[16 + n_stamp] = (unsigned)__builtin_amdgcn_s_memrealtime(); ++n_stamp; } while (0)
#else
#define STAMP() do { } while (0)
#endif
    STAMP();
    PH_P0();
    if (args.ws == nullptr) grid.sync();
    xcd_barrier(bar);
    STAMP();

    for (int l = 0; l < 2; ++l) {
        PH_A(l);
        xcd_barrier(bar); STAMP();
        PH_B1(l);
        xcd_barrier(bar); STAMP();
        PH_SCAN(l);
        PH_POOL();
        xcd_barrier(bar); STAMP();
        PH_C(l);
        xcd_barrier(bar); STAMP();
        PH_D(l);
        xcd_barrier(bar); STAMP();
        PH_E(l, l == 0 ? args.xp : args.out, l == 0 ? args.xs : args.out + (size_t)TP * DM, args.out, l == 0 ? XB : (bf16*)nullptr, ssq + (size_t)(l + 1) * T);
        xcd_barrier(bar); STAMP();
    }
    PH_F(args.out, args.out);
    STAMP();
#if TS1 >= 0
    if (bx == 0 && tid == 0) { const unsigned d1 = MISC[16 + TS1 + 1] - MISC[16 + TS1], d2 = MISC[16 + TS2 + 1] - MISC[16 + TS2];
        const unsigned long long wt = 4ull * d1 + 409600ull * ((d2 + 400u) / 800u);
        const unsigned long long t0 = __builtin_amdgcn_s_memrealtime();
        while (__builtin_amdgcn_s_memrealtime() - t0 < wt) __builtin_amdgcn_s_sleep(32); }
#endif
#ifndef XP
#define XP 0
#endif
#ifndef XN
#define XN 1
#endif
#if XP
    xcd_barrier(bar);
#pragma unroll 1
    for (int rep = 0; rep < XN; ++rep) {
#if XP == 1
        PH_P0();
#elif XP == 2
        PH_A(1);
#elif XP == 3
        PH_B1(1);
#elif XP == 4
        PH_SCAN(1);
#elif XP == 5
        PH_POOL();
#elif XP == 6
        PH_C(1);
#elif XP == 7
        PH_D(1);
#elif XP == 8
        PH_E(1, args.out, args.out + (size_t)TP * DM, (float*)(ws + WS_R1), (bf16*)nullptr, ssq + (size_t)3 * T);
#elif XP == 10
        { pg8::Gemm g{(const char*)XB, (const char*)(BT1 + (size_t)(1) * NCOL * DM), 0, 0, DM * 2, 32, DM};
          pg8::BOrder S; S.init(1, T / 256, NCOL / 256, G, bx); EpiNull E{};
          pg8::gemm_phase<EpiNull, pg8::BOrder>(lds, g, S, E); }
#elif XP == 11
        { pg8::Gemm g{(const char*)MG, (const char*)(BTO + (size_t)(1) * DM * 2048), 0, 0, MGS * 2, 32, 2048};
          pg8::BOrder S; S.init(1, T / 256, DM / 256, G, bx); EpiNull E{};
          pg8::gemm_phase<EpiNull, pg8::BOrder>(lds, g, S, E); }
#elif XP == 12
        { pg8::Gemm g{(const char*)(ws + WS_R2), (const char*)(BTG + (size_t)(1) * 2048 * DM), 0, 0, 32, (unsigned)T * 32u, DM};
          pg8::BOrder S; S.init(1, T / 256, 2048 / 256, G, bx); EpiNull E{};
          pg8::gemm_phase<EpiNull, pg8::BOrder>(lds, g, S, E); }
#elif XP == 9
        PH_F(args.out, (float*)(ws + WS_R1));
#endif
        xcd_barrier(bar);
    }
#endif
}

extern "C" void kernel_launch(void* const* d_in, const int* in_sizes, int n_in, void* d_out, int out_size, void* d_ws, size_t ws_size, hipStream_t stream) {
    static int grid = 0;
    if (grid == 0) {
        if (n_in != 20 || in_sizes[0] != TP * DM || in_sizes[1] != (T - TP) * DM || out_size != T * DM || ws_size < WS_END) {
            fprintf(stderr, "kernel_launch: unexpected shapes (n_in %d, in0 %d, out %d, ws %zu)\n", n_in, n_in > 0 ? in_sizes[0] : -1, out_size, ws_size); grid = -1; return; }
        int dev = 0, cus = 0, per_cu = 0;
        if (hipGetDevice(&dev) != hipSuccess || hipDeviceGetAttribute(&cus, hipDeviceAttributeMultiprocessorCount, dev) != hipSuccess) { grid = -1; return; }
        if (hipFuncSetAttribute((const void*)mk_fwd, hipFuncAttributeMaxDynamicSharedMemorySize, LDS_BYTES) != hipSuccess) { fprintf(stderr, "kernel_launch: hipFuncSetAttribute failed\n"); grid = -1; return; }
        if (hipOccupancyMaxActiveBlocksPerMultiprocessor(&per_cu, (const void*)mk_fwd, NWAVES * 64, LDS_BYTES) != hipSuccess || per_cu < 1) {
            fprintf(stderr, "kernel_launch: occupancy query says %d blocks per CU\n", per_cu); (void)hipGetLastError(); grid = -1; return; }
        grid = cus;
    }
    if (grid < 0) return;
    if (hipMemsetAsync((char*)d_ws + WS_CTL, 0, CTL_ZERO_BYTES, stream) != hipSuccess) { fprintf(stderr, "kernel_launch: memset failed\n"); return; }
    Args a{};
    a.xp = (const float*)d_in[0]; a.xs = (const float*)d_in[1]; a.norm_g = (const float*)d_in[2]; a.w_in = (const float*)d_in[3]; a.pool_w = (const float*)d_in[4]; a.pool_scale = (const float*)d_in[5];
    a.lam_re = (const float*)d_in[6]; a.lam_im = (const float*)d_in[7]; a.log_step = (const float*)d_in[8]; a.b_re = (const float*)d_in[9]; a.b_im = (const float*)d_in[10]; a.c_re = (const float*)d_in[11]; a.c_im = (const float*)d_in[12];
    a.d_skip = (const float*)d_in[13]; a.glu_w1 = (const float*)d_in[14]; a.glu_b1 = (const float*)d_in[15]; a.glu_w2 = (const float*)d_in[16]; a.glu_b2 = (const float*)d_in[17]; a.w_out = (const float*)d_in[18]; a.final_g = (const float*)d_in[19];
    a.out = (float*)d_out; a.ws = (unsigned char*)d_ws;
    void* kargs[] = {&a};
    hipError_t e = hipLaunchCooperativeKernel((const void*)mk_fwd, dim3(grid), dim3(NWAVES * 64), kargs, LDS_BYTES, stream);
    if (e != hipSuccess) fprintf(stderr, "kernel_launch: cooperative launch failed: %s (grid %d)\n", hipGetErrorString(e), grid);
}
```
